# Optimizing an MI355X kernel written in HIP

```python
import math
import jax, jax.numpy as jnp
from jax import lax
import numpy as np

D_MODEL = 1024
BATCH = 8
SEQ = 4096
DEPTH = 2

GRID_W = 64
CTX_LEN = 256
Q_BLOCK = 128
ROPE_THETA = 10000.0
NORM_EPS = 1e-6
MLA_HEADS = 8
MLA_Q_RANK = 384
MLA_KV_RANK = 256
MLA_NOPE = 64
MLA_ROPE = 32
MLA_V = 64
MLA_SCALE = (MLA_NOPE + MLA_ROPE) ** -0.5
GQA_HEADS = 8
GQA_KV_HEADS = 2
GQA_HEAD_DIM = 64
GQA_SCALE = GQA_HEAD_DIM ** -0.5
RWKV_HEADS = 8
RWKV_HEAD = 64
RWKV_WIDTH = RWKV_HEADS * RWKV_HEAD
DECAY_LORA = 64
ICLR_LORA = 64
GATE_LORA = 128
N_DIR = 2
CONV_WIDTH = 3
GN_EPS = 64e-5
N_BRANCH = 3
BRANCH_WIDTH = 512
FFN_HIDDEN = -(-8 * D_MODEL // (3 * 256)) * 256
IN_SPLITS = (MLA_Q_RANK, MLA_KV_RANK, MLA_ROPE,
             GQA_HEADS * GQA_HEAD_DIM, GQA_KV_HEADS * GQA_HEAD_DIM, GQA_KV_HEADS * GQA_HEAD_DIM,
             3 * RWKV_WIDTH, N_DIR * DECAY_LORA, N_DIR * ICLR_LORA, GATE_LORA,
             N_BRANCH * D_MODEL)
IN_WIDTH = sum(IN_SPLITS)
IN_OFFSETS = tuple(np.cumsum(IN_SPLITS)[:-1].tolist())

kernel_name = 'hybrid_mla_gqa_rwkv7_prefix_dit_block'

F32 = jnp.float32


def rms_norm(x, g, eps=NORM_EPS):
    xf = x.astype(F32)
    y = xf * lax.rsqrt(jnp.mean(xf * xf, axis=-1, keepdims=True) + eps)
    return (y * g.astype(F32)).astype(x.dtype)


def axial_rope_tables(row, col, dim):
    quarter = dim // 4
    freqs = ROPE_THETA ** (-jnp.arange(quarter, dtype=F32) / quarter)
    ang = jnp.concatenate([row[:, None] * freqs, col[:, None] * freqs], axis=-1)
    return jnp.cos(ang), jnp.sin(ang)


def apply_rope(x, cos, sin):
    half = x.shape[-1] // 2
    c = cos[None, :, None, :].astype(x.dtype)
    s = sin[None, :, None, :].astype(x.dtype)
    x1, x2 = x[..., :half], x[..., half:]
    return jnp.concatenate([x1 * c - x2 * s, x1 * s + x2 * c], axis=-1)


def short_conv(x, taps):
    t = x.shape[1]
    xp = jnp.pad(x, ((0, 0), (1, 1), (0, 0)))
    return taps[0] * xp[:, :t] + taps[1] * xp[:, 1:t + 1] + taps[2] * xp[:, 2:t + 2]


def block_attention(q, k, v, scale):
    b, t, hk, g, dk = q.shape
    nb = t // Q_BLOCK
    qb = jnp.moveaxis(q.reshape(b, nb, Q_BLOCK, hk, g, dk), 1, 0)

    def one_block(qi):
        s = jnp.einsum('bqhgd,bkhd->bhgqk', qi, k).astype(F32) * scale
        p = jax.nn.softmax(s, axis=-1).astype(v.dtype)
        return jnp.einsum('bhgqk,bkhd->bqhgd', p, v)

    o = lax.map(one_block, qb)
    return jnp.moveaxis(o, 0, 1).reshape(b, t, hk * g * v.shape[-1])


def mla_heads(cq, ckv, kr, lp, rope):
    b, t, _ = cq.shape
    q = (rms_norm(cq, lp['mla_q_norm']) @ lp['mla_w_uq']).reshape(b, t, MLA_HEADS, MLA_NOPE + MLA_ROPE)
    kv = (rms_norm(ckv, lp['mla_kv_norm']) @ lp['mla_w_ukv']).reshape(b, t, MLA_HEADS, MLA_NOPE + MLA_V)
    q_nope, q_rot = q[..., :MLA_NOPE], q[..., MLA_NOPE:]
    k_nope, v = kv[..., :MLA_NOPE], kv[..., MLA_NOPE:]
    k_rot = kr[:, :, None, :]
    if rope is not None:
        q_rot = apply_rope(q_rot, *rope)
        k_rot = apply_rope(k_rot, *rope)
    k = jnp.concatenate([k_nope, jnp.broadcast_to(k_rot, (b, t, MLA_HEADS, MLA_ROPE))], axis=-1)
    q = jnp.concatenate([q_nope, q_rot], axis=-1)
    return q[:, :, :, None, :], k, v


def gqa_heads(qr, kr, vr, lp, rope):
    b, t, _ = qr.shape
    q = rms_norm(qr.reshape(b, t, GQA_HEADS, GQA_HEAD_DIM), lp['gqa_q_norm'])
    k = rms_norm(kr.reshape(b, t, GQA_KV_HEADS, GQA_HEAD_DIM), lp['gqa_k_norm'])
    v = vr.reshape(b, t, GQA_KV_HEADS, GQA_HEAD_DIM)
    if rope is not None:
        q = apply_rope(q, *rope)
        k = apply_rope(k, *rope)
    q = q.reshape(b, t, GQA_KV_HEADS, GQA_HEADS // GQA_KV_HEADS, GQA_HEAD_DIM)
    return q, k, v


def rwkv_inputs(rkv_raw, w_lo, a_lo, g_lo, lp):
    b, t, _ = rkv_raw.shape
    rkv = short_conv(rkv_raw, lp['rwkv_conv'])
    r, k, v = jnp.split(rkv, 3, axis=-1)
    heads = lambda z: z.reshape(z.shape[:-1] + (RWKV_HEADS, RWKV_HEAD))
    w_h = jnp.tanh(w_lo.reshape(b, t, N_DIR, DECAY_LORA))
    w_raw = (jnp.einsum('btdr,drc->dbtc', w_h, lp['rwkv_w2']) + lp['rwkv_w0'][:, None, None, :]).astype(F32)
    decay = jnp.exp(-jnp.exp(-jax.nn.softplus(-w_raw) - 0.5))
    a = jax.nn.sigmoid((jnp.einsum('btdr,drc->dbtc', a_lo.reshape(b, t, N_DIR, ICLR_LORA), lp['rwkv_a2'])
                        + lp['rwkv_a0'][:, None, None, :]).astype(F32))
    g = jax.nn.sigmoid(g_lo) @ lp['rwkv_g2']
    kk = heads(k * lp['rwkv_k_k']).astype(F32)
    kk = kk / jnp.maximum(jnp.sqrt(jnp.sum(kk * kk, axis=-1, keepdims=True)), 1e-12)
    k_mod = k.astype(F32)[None] * (1.0 + (a - 1.0) * lp['rwkv_k_a'].astype(F32))
    return {'r': heads(r).astype(F32), 'w': heads(decay), 'k': heads(k_mod), 'v': heads(v).astype(F32),
            'kk': kk, 'a': heads(a), 'g': g}


def rwkv_scan(state0, r, w, k, v, kk, a):
    def orient(z):
        return jnp.stack([z[0], jnp.flip(z[1], axis=1)])

    shared = lambda z: jnp.broadcast_to(z[None], w.shape)
    xs = tuple(jnp.moveaxis(orient(z), 2, 0) for z in (shared(r), w, k, shared(v), shared(kk), a))

    def step(s, inp):
        r_t, w_t, k_t, v_t, kk_t, a_t = inp
        sa = jnp.einsum('dbhij,dbhj->dbhi', s, -kk_t)
        s = s * w_t[..., None, :] + sa[..., :, None] * (kk_t * a_t)[..., None, :] + v_t[..., :, None] * k_t[..., None, :]
        return s, jnp.einsum('dbhij,dbhj->dbhi', s, r_t)

    s_final, o = lax.scan(step, state0, xs)
    return orient(jnp.moveaxis(o, 0, 2)), s_final


def rwkv_branch(inp, state0, lp):
    o, s_final = rwkv_scan(state0, inp['r'], inp['w'], inp['k'], inp['v'], inp['kk'], inp['a'])
    y = jnp.sum(o, axis=0)
    b, t = y.shape[:2]
    mu = jnp.mean(y, axis=-1, keepdims=True)
    var = jnp.mean(jnp.square(y - mu), axis=-1, keepdims=True)
    y = ((y - mu) * lax.rsqrt(var + GN_EPS)).reshape(b, t, RWKV_WIDTH)
    y = y * lp['rwkv_ln_g'].astype(F32) + lp['rwkv_ln_b'].astype(F32)
    bonus = jnp.sum(jnp.sum(inp['r'][None] * inp['k'] * lp['rwkv_r_k'].astype(F32), axis=-1, keepdims=True)
                    * inp['v'][None], axis=0).reshape(b, t, RWKV_WIDTH)
    out = (y + bonus) * inp['g'].astype(F32)
    return out.astype(inp['g'].dtype), s_final


def merge_branches(branches, gate_raw, w_branch, w_out):
    b, t, _ = gate_raw.shape
    gates = jax.nn.sigmoid(gate_raw.reshape(b, t, N_BRANCH, D_MODEL))
    acc = gates[:, :, 0] * (branches[0] @ w_branch[0])
    for n in range(1, N_BRANCH):
        acc = acc + gates[:, :, n] * (branches[n] @ w_branch[n])
    return acc @ w_out


def token_mixer(h_lat, h_ctx, lp, rope_mla, rope_gqa, need_ctx_out):
    pl = jnp.split(h_lat @ lp['w_in'], IN_OFFSETS, axis=-1)
    pc = jnp.split(h_ctx @ lp['w_in'], IN_OFFSETS, axis=-1)
    qa_l, ka_l, va_l = mla_heads(pl[0], pl[1], pl[2], lp, rope_mla)
    qa_c, ka_c, va_c = mla_heads(pc[0], pc[1], pc[2], lp, None)
    oa_l = block_attention(qa_l, jnp.concatenate([ka_l, ka_c], axis=1), jnp.concatenate([va_l, va_c], axis=1), MLA_SCALE)
    qb_l, kb_l, vb_l = gqa_heads(pl[3], pl[4], pl[5], lp, rope_gqa)
    qb_c, kb_c, vb_c = gqa_heads(pc[3], pc[4], pc[5], lp, None)
    ob_l = block_attention(qb_l, jnp.concatenate([kb_l, kb_c], axis=1), jnp.concatenate([vb_l, vb_c], axis=1), GQA_SCALE)
    b = h_lat.shape[0]
    state0 = jnp.zeros((N_DIR, b, RWKV_HEADS, RWKV_HEAD, RWKV_HEAD), F32)
    oc_c, s_ctx = rwkv_branch(rwkv_inputs(pc[6], pc[7], pc[8], pc[9], lp), state0, lp)
    oc_l, _ = rwkv_branch(rwkv_inputs(pl[6], pl[7], pl[8], pl[9], lp), s_ctx, lp)
    y_lat = merge_branches([oa_l, ob_l, oc_l], pl[10], lp['w_branch'], lp['w_out'])
    if not need_ctx_out:
        return y_lat, None
    oa_c = block_attention(qa_c, ka_c, va_c, MLA_SCALE)
    ob_c = block_attention(qb_c, kb_c, vb_c, GQA_SCALE)
    y_ctx = merge_branches([oa_c, ob_c, oc_c], pc[10], lp['w_branch'], lp['w_out'])
    return y_lat, y_ctx


def swiglu(h, w_in, w_out):
    gate, up = jnp.split(h @ w_in, 2, axis=-1)
    return (jax.nn.silu(gate) * up) @ w_out


def setup_inputs(seed: int = 0) -> dict:
    key = jax.random.key(seed)
    counter = iter(range(1000))
    L, D = DEPTH, D_MODEL

    def nrm(shape, scale):
        return scale * jax.random.normal(jax.random.fold_in(key, next(counter)), shape, F32)

    def gain(*shape):
        return 1.0 + nrm((L,) + shape, 0.05)

    return {
        'x': nrm((BATCH, SEQ, D), 1.0),
        'c': nrm((BATCH, D), 1.0),
        'ctx': nrm((BATCH, CTX_LEN, D), 1.0),
        'c_ctx': nrm((D,), 1.0),
        'ada_w': nrm((L, D, 6 * D), 0.5 * D ** -0.5),
        'ada_b': nrm((L, 6 * D), 0.02),
        'attn_pre_g': gain(D),
        'attn_post_g': gain(D),
        'ffn_pre_g': gain(D),
        'ffn_post_g': gain(D),
        'w_in': nrm((L, D, IN_WIDTH), D ** -0.5),
        'mla_q_norm': gain(MLA_Q_RANK),
        'mla_kv_norm': gain(MLA_KV_RANK),
        'mla_w_uq': nrm((L, MLA_Q_RANK, MLA_HEADS * (MLA_NOPE + MLA_ROPE)), MLA_Q_RANK ** -0.5),
        'mla_w_ukv': nrm((L, MLA_KV_RANK, MLA_HEADS * (MLA_NOPE + MLA_V)), MLA_KV_RANK ** -0.5),
        'gqa_q_norm': gain(GQA_HEAD_DIM),
        'gqa_k_norm': gain(GQA_HEAD_DIM),
        'rwkv_conv': nrm((L, CONV_WIDTH, 3 * RWKV_WIDTH), 0.1) + jnp.array([0.25, 0.5, 0.25], F32)[None, :, None],
        'rwkv_w0': nrm((L, N_DIR, RWKV_WIDTH), 1.0) - 2.0,
        'rwkv_w2': nrm((L, N_DIR, DECAY_LORA, RWKV_WIDTH), 0.1),
        'rwkv_a0': nrm((L, N_DIR, RWKV_WIDTH), 0.5),
        'rwkv_a2': nrm((L, N_DIR, ICLR_LORA, RWKV_WIDTH), 0.1),
        'rwkv_g2': nrm((L, GATE_LORA, RWKV_WIDTH), GATE_LORA ** -0.5),
        'rwkv_k_k': 0.85 + nrm((L, RWKV_WIDTH), 0.05),
        'rwkv_k_a': 1.0 + nrm((L, RWKV_WIDTH), 0.05),
        'rwkv_r_k': nrm((L, RWKV_HEADS, RWKV_HEAD), 0.1),
        'rwkv_ln_g': gain(RWKV_WIDTH),
        'rwkv_ln_b': nrm((L, RWKV_WIDTH), 0.02),
        'w_branch': nrm((L, N_BRANCH, BRANCH_WIDTH, D), BRANCH_WIDTH ** -0.5),
        'w_out': nrm((L, D, D), D ** -0.5),
        'ffn_w_in': nrm((L, D, 2 * FFN_HIDDEN), D ** -0.5),
        'ffn_w_out': nrm((L, FFN_HIDDEN, D), FFN_HIDDEN ** -0.5),
    }


def reference(x, c, ctx, c_ctx, ada_w, ada_b, attn_pre_g, attn_post_g, ffn_pre_g, ffn_post_g,
              w_in, mla_q_norm, mla_kv_norm, mla_w_uq, mla_w_ukv, gqa_q_norm, gqa_k_norm,
              rwkv_conv, rwkv_w0, rwkv_w2, rwkv_a0, rwkv_a2, rwkv_g2, rwkv_k_k, rwkv_k_a, rwkv_r_k,
              rwkv_ln_g, rwkv_ln_b, w_branch, w_out, ffn_w_in, ffn_w_out):
    n = x.shape[1]
    rows = n // GRID_W
    ri, ci = jnp.meshgrid(jnp.arange(rows, dtype=F32), jnp.arange(GRID_W, dtype=F32), indexing='ij')
    row, col = ri.reshape(-1), ci.reshape(-1)
    rope_mla = axial_rope_tables(row, col, MLA_ROPE)
    rope_gqa = axial_rope_tables(row, col, GQA_HEAD_DIM)
    silu_c = jax.nn.silu(c)
    silu_cc = jax.nn.silu(c_ctx)
    for l in range(DEPTH):
        last = l == DEPTH - 1
        lp = dict(w_in=w_in[l], mla_q_norm=mla_q_norm[l], mla_kv_norm=mla_kv_norm[l], mla_w_uq=mla_w_uq[l],
                  mla_w_ukv=mla_w_ukv[l], gqa_q_norm=gqa_q_norm[l], gqa_k_norm=gqa_k_norm[l],
                  rwkv_conv=rwkv_conv[l], rwkv_w0=rwkv_w0[l], rwkv_w2=rwkv_w2[l], rwkv_a0=rwkv_a0[l],
                  rwkv_a2=rwkv_a2[l], rwkv_g2=rwkv_g2[l], rwkv_k_k=rwkv_k_k[l], rwkv_k_a=rwkv_k_a[l],
                  rwkv_r_k=rwkv_r_k[l], rwkv_ln_g=rwkv_ln_g[l], rwkv_ln_b=rwkv_ln_b[l],
                  w_branch=w_branch[l], w_out=w_out[l])
        sh1, sc1, g1, sh2, sc2, g2 = jnp.split((silu_c @ ada_w[l] + ada_b[l])[:, None, :], 6, axis=-1)
        csh1, csc1, cg1, csh2, csc2, cg2 = jnp.split(silu_cc @ ada_w[l] + ada_b[l], 6, axis=-1)
        h_lat = rms_norm(x, attn_pre_g[l]) * (1.0 + sc1) + sh1
        h_ctx = rms_norm(ctx, attn_pre_g[l]) * (1.0 + csc1) + csh1
        y_lat, y_ctx = token_mixer(h_lat, h_ctx, lp, rope_mla, rope_gqa, not last)
        x = x + g1 * rms_norm(y_lat, attn_post_g[l])
        f_lat = swiglu(rms_norm(x, ffn_pre_g[l]) * (1.0 + sc2) + sh2, ffn_w_in[l], ffn_w_out[l])
        x = x + g2 * rms_norm(f_lat, ffn_post_g[l])
        if not last:
            ctx = ctx + cg1 * rms_norm(y_ctx, attn_post_g[l])
            f_ctx = swiglu(rms_norm(ctx, ffn_pre_g[l]) * (1.0 + csc2) + csh2, ffn_w_in[l], ffn_w_out[l])
            ctx = ctx + cg2 * rms_norm(f_ctx, ffn_post_g[l])
    return x
```

```cpp
#include <hip/hip_runtime.h>
#include <hip/hip_cooperative_groups.h>
#include <cstdio>
namespace cg = cooperative_groups;

#ifndef MEGA
#define MEGA 1
#endif
#ifndef DUPMASK
#define DUPMASK 0
#endif
#ifndef DUPMODE
#define DUPMODE 0
#endif
#ifndef BENCH
#define BENCH 0
#endif

typedef _Float16 h16;
typedef h16 h16x8 __attribute__((ext_vector_type(8)));
typedef h16 h16x4 __attribute__((ext_vector_type(4)));
typedef h16 h16x2 __attribute__((ext_vector_type(2)));
typedef float f32x16 __attribute__((ext_vector_type(16)));
typedef float f32x4 __attribute__((ext_vector_type(4)));
typedef float f32x2 __attribute__((ext_vector_type(2)));
typedef unsigned u32x4 __attribute__((ext_vector_type(4)));
typedef __bf16 b16;
typedef b16 b16x8 __attribute__((ext_vector_type(8)));
typedef b16 b16x4 __attribute__((ext_vector_type(4)));
#define MFMAB(a, b, c) __builtin_amdgcn_mfma_f32_32x32x16_bf16((a), (b), (c), 0, 0, 0)

#define DI __device__ __forceinline__
#define MFMA(a, b, c) __builtin_amdgcn_mfma_f32_32x32x16_f16((a), (b), (c), 0, 0, 0)

enum { I_X = 0, I_C, I_CTX, I_CCTX, I_ADAW, I_ADAB, I_APRE, I_APOST, I_FPRE, I_FPOST, I_WIN, I_QNORM, I_KVNORM, I_WUQ, I_WUKV,
       I_GQN, I_GKN, I_CONV, I_W0, I_W2, I_A0, I_A2, I_G2, I_KK, I_KA, I_RK, I_LNG, I_LNB, I_WB, I_WOUT, I_FIN, I_FOUT, N_IN };

struct P { const float* in[N_IN]; float* out; char* ws; };

constexpr int TL = 32768, TA = 34816, SA = 4352;
constexpr float EPS = 1e-6f;
constexpr float LOG2E = 1.4426950408889634f;

constexpr size_t WO_WIN = 0, WO_UQ = WO_WIN + (size_t)6432 * 1024, WO_UKV = WO_UQ + 768 * 384, WO_G2 = WO_UKV + 1024 * 256,
                 WO_WB = WO_G2 + 512 * 128, WO_WOUT = WO_WB + (size_t)3 * 1024 * 512, WO_FIN = WO_WOUT + 1024 * 1024,
                 WO_FOUT = WO_FIN + (size_t)5632 * 1024, WO_END = WO_FOUT + (size_t)1024 * 2816;
constexpr size_t OFF_W16 = 0;
constexpr size_t OFF_MOD = OFF_W16 + WO_END * 2;
constexpr size_t OFF_ROPEM = OFF_MOD + (size_t)2 * 9 * 6144 * 4;
constexpr size_t OFF_ROPEG = OFF_ROPEM + (size_t)4096 * 16 * 8;
constexpr size_t OFF_XC = OFF_ROPEG + (size_t)4096 * 32 * 8;
constexpr size_t OFF_BS = OFF_XC + (size_t)2048 * 1024 * 4;
constexpr size_t OFF_KROT = OFF_BS + (size_t)2 * TA * 8 * 4;
constexpr size_t OFF_HB = OFF_KROT + (size_t)TA * 32 * 2;
constexpr size_t OFF_R1 = OFF_HB + (size_t)TA * 1024 * 2;
constexpr size_t OFF_X = OFF_R1 + (size_t)TA * 1920 * 2;
constexpr size_t OFF_QM = OFF_X + (size_t)TA * 1024 * 2;
constexpr size_t OFF_KN = OFF_QM + (size_t)TA * 768 * 2;
constexpr size_t OFF_VMT = OFF_KN + (size_t)TA * 512 * 2;
constexpr size_t OFF_QG = OFF_VMT + (size_t)TA * 512 * 2;
constexpr size_t OFF_KG = OFF_QG + (size_t)TA * 512 * 2;
constexpr size_t OFF_VGT = OFF_KG + (size_t)TA * 128 * 2;
constexpr size_t OFF_CTR = OFF_VGT + (size_t)TA * 128 * 2;
constexpr size_t OFF_BAR = OFF_CTR + 256;
constexpr size_t OFF_END = OFF_BAR + 3456 * 4;
constexpr size_t OFF_ACC = OFF_QM;
constexpr size_t OFF_HRE = OFF_QM + (size_t)TA * 1024 * 2;

constexpr int SMEM_BYTES = 73728;

DI int TIDX() { int t = threadIdx.x; asm volatile("" : "+v"(t)); return t; }
DI int BIDX() { int b = blockIdx.x; asm volatile("" : "+s"(b)); return b; }
DI float shx(float v, int mask) {
  const int lane = TIDX() & 63;
  return __int_as_float(__builtin_amdgcn_ds_bpermute((lane ^ mask) << 2, __float_as_int(v)));
}
#define XB_TMO      128
#define XB_XCNT(j)  (256  + 64 * (j))
#define XB_XSUB(j)  (1280 + 64 * (j))
#define XB_XGEN(j)  (2304 + 64 * (j))
#define XB_TOP      3328
#define XB_TOPGEN   3392
#define XB_SPIN_CAP (1u << 20)
#define LAS __attribute__((address_space(3)))
DI unsigned xb_ld(unsigned* p) { return __hip_atomic_load(p, __ATOMIC_RELAXED, __HIP_MEMORY_SCOPE_AGENT); }
DI unsigned xb_add(unsigned* p, unsigned v) { return __hip_atomic_fetch_add(p, v, __ATOMIC_RELAXED, __HIP_MEMORY_SCOPE_AGENT); }
DI unsigned xb_xcc_id() { return (unsigned)__builtin_amdgcn_s_getreg((3 << 11) | 20) & 0xFu; }
#define XB_SPIN(cond, bar) do { unsigned _sp = 0; while (cond) { __builtin_amdgcn_s_sleep(1); \
    if ((++_sp & 255u) == 0u) { if (xb_ld(&(bar)[XB_TMO])) break; if (_sp > XB_SPIN_CAP) { atomicAdd(&(bar)[XB_TMO], 1u); break; } } } } while (0)
struct XcdBarrier { unsigned* bar; unsigned x; volatile LAS unsigned* st; };
DI XcdBarrier xcd_barrier_post(unsigned* bar, volatile LAS unsigned* st) {
  XcdBarrier b; b.bar = bar; b.x = xb_xcc_id(); b.st = st;
  if (threadIdx.x == 0) (void)xb_add(&bar[XB_XCNT(b.x)], 1u);
  return b;
}
DI void xcd_barrier_complete(unsigned* bar, unsigned x, unsigned& nloc, unsigned& nx) {
  const unsigned G = gridDim.x * gridDim.y * gridDim.z;
  unsigned sum, cnt, mine, sp = 0u;
  for (;;) {
    sum = 0u; cnt = 0u; mine = 0u;
#pragma unroll
    for (unsigned j = 0; j < 16; ++j) { const unsigned c = xb_ld(&bar[XB_XCNT(j)]); sum += c; cnt += (c > 0u) ? 1u : 0u; mine = (j == x) ? c : mine; }
    if (sum == G) break;
    __builtin_amdgcn_s_sleep(1);
    if ((++sp & 255u) == 0u) { if (xb_ld(&bar[XB_TMO])) break; if (sp > XB_SPIN_CAP) { atomicAdd(&bar[XB_TMO], 1u); break; } }
  }
  nloc = mine > 0u ? mine : 1u; nx = cnt > 0u ? cnt : 1u;
}
DI void xcd_barrier(const XcdBarrier& b) {
  asm volatile("s_waitcnt vmcnt(0)" ::: "memory");
  __syncthreads();
  if (threadIdx.x == 0) {
    unsigned* bar = b.bar;
    __builtin_amdgcn_s_waitcnt(0);
    unsigned nloc = b.st[0], nx = b.st[1];
    if (nloc == 0u) { xcd_barrier_complete(bar, b.x, nloc, nx); b.st[0] = nloc; b.st[1] = nx; }
    const unsigned old = xb_add(&bar[XB_XSUB(b.x)], 1u);
    const unsigned gen = old / nloc;
    if (old + 1u == (gen + 1u) * nloc) {
      __builtin_amdgcn_fence(__ATOMIC_RELEASE, "agent");
      asm volatile("s_waitcnt vmcnt(0)" ::: "memory");
      const unsigned og = xb_add(&bar[XB_TOP], 1u);
      const unsigned tg = og / nx;
      if (og + 1u == (tg + 1u) * nx) xb_add(&bar[XB_TOPGEN], 1u);
      else XB_SPIN(xb_ld(&bar[XB_TOPGEN]) == tg, bar);
      __builtin_amdgcn_fence(__ATOMIC_ACQUIRE, "agent");
      xb_add(&bar[XB_XGEN(b.x)], 1u);
      asm volatile("s_waitcnt vmcnt(0)" ::: "memory");
    } else {
      XB_SPIN(xb_ld(&bar[XB_XGEN(b.x)]) == gen, bar);
      __builtin_amdgcn_fence(__ATOMIC_ACQUIRE, "agent");
      asm volatile("s_waitcnt vmcnt(0)" ::: "memory");
    }
  }
  __syncthreads();
}

DI float x32_sum(float v) {
  auto r = __builtin_amdgcn_permlane32_swap(__float_as_uint(v), __float_as_uint(v), false, false);
  return __uint_as_float(r[0]) + __uint_as_float(r[1]);
}
DI float x32_max(float v) {
  auto r = __builtin_amdgcn_permlane32_swap(__float_as_uint(v), __float_as_uint(v), false, false);
  return fmaxf(__uint_as_float(r[0]), __uint_as_float(r[1]));
}
DI float wave_sum(float v) {
  v += __int_as_float(__builtin_amdgcn_mov_dpp(__float_as_int(v), 0xB1, 0xF, 0xF, true));
  v += __int_as_float(__builtin_amdgcn_mov_dpp(__float_as_int(v), 0x4E, 0xF, 0xF, true));
  v += __int_as_float(__builtin_amdgcn_mov_dpp(__float_as_int(v), 0x141, 0xF, 0xF, true));
  v += __int_as_float(__builtin_amdgcn_mov_dpp(__float_as_int(v), 0x140, 0xF, 0xF, true));
  v += __int_as_float(__builtin_amdgcn_ds_swizzle(__float_as_int(v), 0x401F));
  return x32_sum(v);
}
DI float quad_sum(float v) {
  v += __int_as_float(__builtin_amdgcn_mov_dpp(__float_as_int(v), 0xB1, 0xF, 0xF, true));
  v += __int_as_float(__builtin_amdgcn_mov_dpp(__float_as_int(v), 0x4E, 0xF, 0xF, true));
  return v;
}
DI float sigmoidf_(float x) { return __builtin_amdgcn_rcpf(1.f + __expf(-x)); }
DI int srow_of(int row) {
  if (row < TL) return (row >> 12) * SA + (row & 4095);
  int rc = row - TL;
  return (rc >> 8) * SA + 4096 + (rc & 255);
}

constexpr int LSTR = 72;
DI void gemm_tile(const h16* __restrict__ A, int lda, const h16* __restrict__ B, int ldb, int K, f32x16 (&acc)[2][2], h16* sm) {
  const int tid = TIDX(), lane = tid & 63, w = tid >> 6, wm = w >> 1, wn = w & 1, r = lane & 31, hh = lane >> 5;
  const unsigned ao = (unsigned)(tid >> 3) * (unsigned)lda + (unsigned)(tid & 7) * 8u;
  const unsigned bo = (unsigned)(tid >> 3) * (unsigned)ldb + (unsigned)(tid & 7) * 8u;
  const h16* ag = A;
  const h16* bg = B;
  u32x4 ra[4], rb[4];
#pragma unroll
  for (int i = 0; i < 4; ++i) {
    ra[i] = *(const u32x4*)(ag + (ao + (unsigned)i * 32u * (unsigned)lda));
    rb[i] = *(const u32x4*)(bg + (bo + (unsigned)i * 32u * (unsigned)ldb));
  }
  const int nk = K >> 6;
  const int wofs = (tid >> 3) * LSTR + (tid & 7) * 8;
  for (int kt = 0; kt < nk; ++kt) {
    h16* sa = sm + (kt & 1) * (2 * 128 * LSTR);
    h16* sb = sa + 128 * LSTR;
#pragma unroll
    for (int i = 0; i < 4; ++i) {
      *(u32x4*)(sa + wofs + i * 32 * LSTR) = ra[i];
      *(u32x4*)(sb + wofs + i * 32 * LSTR) = rb[i];
    }
    __syncthreads();
    const h16* pa = sa + (wm * 64 + r) * LSTR + hh * 8;
    const h16* pb = sb + (wn * 64 + r) * LSTR + hh * 8;
    h16x8 fa[2][2], fb[2][2];
    fa[0][0] = *(const h16x8*)(pa); fa[0][1] = *(const h16x8*)(pa + 32 * LSTR);
    fb[0][0] = *(const h16x8*)(pb); fb[0][1] = *(const h16x8*)(pb + 32 * LSTR);
    __builtin_amdgcn_sched_barrier(0);
    if (kt + 1 < nk) {
      ag += 64; bg += 64;
#pragma unroll
      for (int i = 0; i < 4; ++i) {
        ra[i] = *(const u32x4*)(ag + (ao + (unsigned)i * 32u * (unsigned)lda));
        rb[i] = *(const u32x4*)(bg + (bo + (unsigned)i * 32u * (unsigned)ldb));
      }
    }
    __builtin_amdgcn_sched_barrier(0);
#pragma unroll
    for (int ks = 0; ks < 4; ++ks) {
      const int cur = ks & 1, nxt = cur ^ 1;
      if (ks < 3) {
        fa[nxt][0] = *(const h16x8*)(pa + (ks + 1) * 16); fa[nxt][1] = *(const h16x8*)(pa + 32 * LSTR + (ks + 1) * 16);
        fb[nxt][0] = *(const h16x8*)(pb + (ks + 1) * 16); fb[nxt][1] = *(const h16x8*)(pb + 32 * LSTR + (ks + 1) * 16);
      }
      acc[0][0] = MFMA(fa[cur][0], fb[cur][0], acc[0][0]);
      acc[0][1] = MFMA(fa[cur][0], fb[cur][1], acc[0][1]);
      acc[1][0] = MFMA(fa[cur][1], fb[cur][0], acc[1][0]);
      acc[1][1] = MFMA(fa[cur][1], fb[cur][1], acc[1][1]);
      __builtin_amdgcn_sched_barrier(0);
    }
  }
  __syncthreads();
}
DI void gemm_tile_deep(const h16* __restrict__ A, int lda, const h16* __restrict__ B, int ldb, int K, f32x16 (&acc)[2][2], h16* sm) {
  const int tid = TIDX(), lane = tid & 63, w = tid >> 6, wm = w >> 1, wn = w & 1, r = lane & 31, hh = lane >> 5;
  const unsigned ao = (unsigned)(tid >> 3) * (unsigned)lda + (unsigned)(tid & 7) * 8u;
  const unsigned bo = (unsigned)(tid >> 3) * (unsigned)ldb + (unsigned)(tid & 7) * 8u;
  const h16* ag = A;
  const h16* bg = B;
  u32x4 ra0[4], rb0[4], ra1[4], rb1[4];
#pragma unroll
  for (int i = 0; i < 4; ++i) {
    ra0[i] = *(const u32x4*)(ag + (ao + (unsigned)i * 32u * (unsigned)lda));
    rb0[i] = *(const u32x4*)(bg + (bo + (unsigned)i * 32u * (unsigned)ldb));
  }
  ag += 64; bg += 64;
#pragma unroll
  for (int i = 0; i < 4; ++i) {
    ra1[i] = *(const u32x4*)(ag + (ao + (unsigned)i * 32u * (unsigned)lda));
    rb1[i] = *(const u32x4*)(bg + (bo + (unsigned)i * 32u * (unsigned)ldb));
  }
  const int nk = K >> 6;
  const int wofs = (tid >> 3) * LSTR + (tid & 7) * 8;
#define DEEP_HALF(RA, RB, BUF, KT)                                                                       \
  {                                                                                                      \
    h16* sa = sm + (BUF) * (2 * 128 * LSTR);                                                             \
    h16* sb = sa + 128 * LSTR;                                                                           \
    _Pragma("unroll") for (int i = 0; i < 4; ++i) {                                                      \
      *(u32x4*)(sa + wofs + i * 32 * LSTR) = RA[i];                                                      \
      *(u32x4*)(sb + wofs + i * 32 * LSTR) = RB[i];                                                      \
    }                                                                                                    \
    __syncthreads();                                                                                     \
    const h16* pa = sa + (wm * 64 + r) * LSTR + hh * 8;                                                  \
    const h16* pb = sb + (wn * 64 + r) * LSTR + hh * 8;                                                  \
    h16x8 fa[2][2], fb[2][2];                                                                            \
    fa[0][0] = *(const h16x8*)(pa); fa[0][1] = *(const h16x8*)(pa + 32 * LSTR);                          \
    fb[0][0] = *(const h16x8*)(pb); fb[0][1] = *(const h16x8*)(pb + 32 * LSTR);                          \
    __builtin_amdgcn_sched_barrier(0);                                                                   \
    if ((KT) + 2 < nk) {                                                                                 \
      ag += 64; bg += 64;                                                                                \
      _Pragma("unroll") for (int i = 0; i < 4; ++i) {                                                    \
        RA[i] = *(const u32x4*)(ag + (ao + (unsigned)i * 32u * (unsigned)lda));                          \
        RB[i] = *(const u32x4*)(bg + (bo + (unsigned)i * 32u * (unsigned)ldb));                          \
      }                                                                                                  \
    }                                                                                                    \
    __builtin_amdgcn_sched_barrier(0);                                                                   \
    _Pragma("unroll") for (int ks = 0; ks < 4; ++ks) {                                                   \
      const int cur = ks & 1, nxt = cur ^ 1;                                                             \
      if (ks < 3) {                                                                                      \
        fa[nxt][0] = *(const h16x8*)(pa + (ks + 1) * 16); fa[nxt][1] = *(const h16x8*)(pa + 32 * LSTR + (ks + 1) * 16); \
        fb[nxt][0] = *(const h16x8*)(pb + (ks + 1) * 16); fb[nxt][1] = *(const h16x8*)(pb + 32 * LSTR + (ks + 1) * 16); \
      }                                                                                                  \
      acc[0][0] = MFMA(fa[cur][0], fb[cur][0], acc[0][0]);                                               \
      acc[0][1] = MFMA(fa[cur][0], fb[cur][1], acc[0][1]);                                               \
      acc[1][0] = MFMA(fa[cur][1], fb[cur][0], acc[1][0]);                                               \
      acc[1][1] = MFMA(fa[cur][1], fb[cur][1], acc[1][1]);                                               \
      __builtin_amdgcn_sched_barrier(0);                                                                 \
    }                                                                                                    \
  }
  for (int kt = 0; kt < nk; kt += 2) {
    DEEP_HALF(ra0, rb0, 0, kt)
    DEEP_HALF(ra1, rb1, 1, kt + 1)
  }
#undef DEEP_HALF
  __syncthreads();
}
DI void gemm_tile_c(const h16* __restrict__ A, int lda, const h16* __restrict__ B, int ldb, int K, f32x16 (&acc)[2][2], h16* sm,
                    u32x4 (&ra)[4], u32x4 (&rb)[4], bool pre, const h16* __restrict__ nA, int nlda, const h16* __restrict__ nB, int nldb) {
  const int tid = TIDX(), lane = tid & 63, w = tid >> 6, wm = w >> 1, wn = w & 1, r = lane & 31, hh = lane >> 5;
  const unsigned ao = (unsigned)(tid >> 3) * (unsigned)lda + (unsigned)(tid & 7) * 8u;
  const unsigned bo = (unsigned)(tid >> 3) * (unsigned)ldb + (unsigned)(tid & 7) * 8u;
  const h16* ag = A;
  const h16* bg = B;
  if (!pre) {
#pragma unroll
    for (int i = 0; i < 4; ++i) {
      ra[i] = *(const u32x4*)(ag + (ao + (unsigned)i * 32u * (unsigned)lda));
      rb[i] = *(const u32x4*)(bg + (bo + (unsigned)i * 32u * (unsigned)ldb));
    }
  }
  const int nk = K >> 6;
  const int wofs = (tid >> 3) * LSTR + (tid & 7) * 8;
  for (int kt = 0; kt < nk; ++kt) {
    h16* sa = sm + (kt & 1) * (2 * 128 * LSTR);
    h16* sb = sa + 128 * LSTR;
#pragma unroll
    for (int i = 0; i < 4; ++i) {
      *(u32x4*)(sa + wofs + i * 32 * LSTR) = ra[i];
      *(u32x4*)(sb + wofs + i * 32 * LSTR) = rb[i];
    }
    __syncthreads();
    const h16* pa = sa + (wm * 64 + r) * LSTR + hh * 8;
    const h16* pb = sb + (wn * 64 + r) * LSTR + hh * 8;
    h16x8 fa[2][2], fb[2][2];
    fa[0][0] = *(const h16x8*)(pa); fa[0][1] = *(const h16x8*)(pa + 32 * LSTR);
    fb[0][0] = *(const h16x8*)(pb); fb[0][1] = *(const h16x8*)(pb + 32 * LSTR);
    __builtin_amdgcn_sched_barrier(0);
    if (kt + 1 < nk) {
      ag += 64; bg += 64;
#pragma unroll
      for (int i = 0; i < 4; ++i) {
        ra[i] = *(const u32x4*)(ag + (ao + (unsigned)i * 32u * (unsigned)lda));
        rb[i] = *(const u32x4*)(bg + (bo + (unsigned)i * 32u * (unsigned)ldb));
      }
    } else if (nA != nullptr) {
      const unsigned nao = (unsigned)(tid >> 3) * (unsigned)nlda + (unsigned)(tid & 7) * 8u;
      const unsigned nbo = (unsigned)(tid >> 3) * (unsigned)nldb + (unsigned)(tid & 7) * 8u;
#pragma unroll
      for (int i = 0; i < 4; ++i) {
        ra[i] = *(const u32x4*)(nA + (nao + (unsigned)i * 32u * (unsigned)nlda));
        rb[i] = *(const u32x4*)(nB + (nbo + (unsigned)i * 32u * (unsigned)nldb));
      }
    }
    __builtin_amdgcn_sched_barrier(0);
#pragma unroll
    for (int ks = 0; ks < 4; ++ks) {
      const int cur = ks & 1, nxt = cur ^ 1;
      if (ks < 3) {
        fa[nxt][0] = *(const h16x8*)(pa + (ks + 1) * 16); fa[nxt][1] = *(const h16x8*)(pa + 32 * LSTR + (ks + 1) * 16);
        fb[nxt][0] = *(const h16x8*)(pb + (ks + 1) * 16); fb[nxt][1] = *(const h16x8*)(pb + 32 * LSTR + (ks + 1) * 16);
      }
      acc[0][0] = MFMA(fa[cur][0], fb[cur][0], acc[0][0]);
      acc[0][1] = MFMA(fa[cur][0], fb[cur][1], acc[0][1]);
      acc[1][0] = MFMA(fa[cur][1], fb[cur][0], acc[1][0]);
      acc[1][1] = MFMA(fa[cur][1], fb[cur][1], acc[1][1]);
      __builtin_amdgcn_sched_barrier(0);
    }
  }
  __syncthreads();
}
DI void zero_acc(f32x16 (&acc)[2][2]) {
#pragma unroll
  for (int a = 0; a < 2; ++a)
#pragma unroll
    for (int b = 0; b < 2; ++b)
#pragma unroll
      for (int i = 0; i < 16; ++i) acc[a][b][i] = 0.f;
}
constexpr int LS2 = 40;
template <class BR>
DI void gemm_tile_w(const h16* __restrict__ A, int lda, const h16* __restrict__ B, int ldb, BR brow, int K, f32x16 (&acc)[4][2], h16* sm) {
  const int tid = TIDX(), lane = tid & 63, w = tid >> 6, wm = w >> 1, wn = w & 1, r = lane & 31, hh = lane >> 5;
  const unsigned ao = (unsigned)(tid >> 2) * (unsigned)lda + (unsigned)(tid & 3) * 8u;
  const unsigned bo0 = (unsigned)brow(tid >> 2) * (unsigned)ldb + (unsigned)(tid & 3) * 8u;
  const unsigned bo1 = (unsigned)brow((tid >> 2) + 64) * (unsigned)ldb + (unsigned)(tid & 3) * 8u;
  const h16* ag = A;
  const h16* bg = B;
  u32x4 ra0[4], rb0[2], ra1[4], rb1[2];
#pragma unroll
  for (int i = 0; i < 4; ++i) ra0[i] = *(const u32x4*)(ag + (ao + (unsigned)i * 64u * (unsigned)lda));
  rb0[0] = *(const u32x4*)(bg + bo0);
  rb0[1] = *(const u32x4*)(bg + bo1);
  ag += 32; bg += 32;
#pragma unroll
  for (int i = 0; i < 4; ++i) ra1[i] = *(const u32x4*)(ag + (ao + (unsigned)i * 64u * (unsigned)lda));
  rb1[0] = *(const u32x4*)(bg + bo0);
  rb1[1] = *(const u32x4*)(bg + bo1);
  const int nk = K >> 5;
  const int wofs = (tid >> 2) * LS2 + (tid & 3) * 8;
#define WIDE_HALF(RA, RB, BUF, KT)                                                                       \
  {                                                                                                      \
    h16* sa = sm + (BUF) * (384 * LS2);                                                                  \
    h16* sb = sa + 256 * LS2;                                                                            \
    _Pragma("unroll") for (int i = 0; i < 4; ++i) *(u32x4*)(sa + wofs + i * 64 * LS2) = RA[i];           \
    *(u32x4*)(sb + wofs) = RB[0];                                                                        \
    *(u32x4*)(sb + wofs + 64 * LS2) = RB[1];                                                             \
    __syncthreads();                                                                                     \
    const h16* pa = sa + (wm * 128 + r) * LS2 + hh * 8;                                                  \
    const h16* pb = sb + (wn * 64 + r) * LS2 + hh * 8;                                                   \
    h16x8 fa0[4], fb0[2], fa1[4], fb1[2];                                                                \
    _Pragma("unroll") for (int mi = 0; mi < 4; ++mi) fa0[mi] = *(const h16x8*)(pa + mi * 32 * LS2);      \
    fb0[0] = *(const h16x8*)(pb); fb0[1] = *(const h16x8*)(pb + 32 * LS2);                               \
    __builtin_amdgcn_sched_barrier(0);                                                                   \
    if ((KT) + 2 < nk) {                                                                                 \
      ag += 32; bg += 32;                                                                                \
      _Pragma("unroll") for (int i = 0; i < 4; ++i) RA[i] = *(const u32x4*)(ag + (ao + (unsigned)i * 64u * (unsigned)lda)); \
      RB[0] = *(const u32x4*)(bg + bo0);                                                                 \
      RB[1] = *(const u32x4*)(bg + bo1);                                                                 \
    }                                                                                                    \
    __builtin_amdgcn_sched_barrier(0);                                                                   \
    _Pragma("unroll") for (int mi = 0; mi < 4; ++mi) fa1[mi] = *(const h16x8*)(pa + mi * 32 * LS2 + 16); \
    fb1[0] = *(const h16x8*)(pb + 16); fb1[1] = *(const h16x8*)(pb + 32 * LS2 + 16);                     \
    _Pragma("unroll") for (int mi = 0; mi < 4; ++mi) {                                                   \
      acc[mi][0] = MFMA(fa0[mi], fb0[0], acc[mi][0]);                                                    \
      acc[mi][1] = MFMA(fa0[mi], fb0[1], acc[mi][1]);                                                    \
    }                                                                                                    \
    __builtin_amdgcn_sched_barrier(0);                                                                   \
    _Pragma("unroll") for (int mi = 0; mi < 4; ++mi) {                                                   \
      acc[mi][0] = MFMA(fa1[mi], fb1[0], acc[mi][0]);                                                    \
      acc[mi][1] = MFMA(fa1[mi], fb1[1], acc[mi][1]);                                                    \
    }                                                                                                    \
    __builtin_amdgcn_sched_barrier(0);                                                                   \
  }
  for (int kt = 0; kt < nk; kt += 2) {
    WIDE_HALF(ra0, rb0, 0, kt)
    WIDE_HALF(ra1, rb1, 1, kt + 1)
  }
#undef WIDE_HALF
  __syncthreads();
}
DI void zero_acc_w(f32x16 (&acc)[4][2]) {
#pragma unroll
  for (int a = 0; a < 4; ++a)
#pragma unroll
    for (int b = 0; b < 2; ++b)
#pragma unroll
      for (int i = 0; i < 16; ++i) acc[a][b][i] = 0.f;
}
template <class F>
DI void epi_foreach_w(f32x16 (&acc)[4][2], int m0, int n0, F f) {
  const int lane = TIDX() & 63, w = TIDX() >> 6, wm = w >> 1, wn = w & 1, hh = lane >> 5, c = lane & 31;
#pragma unroll
  for (int mi = 0; mi < 4; ++mi)
#pragma unroll
    for (int ni = 0; ni < 2; ++ni) {
      int rb = m0 + wm * 128 + mi * 32 + 4 * hh;
      asm volatile("" : "+v"(rb));
      f(rb, n0 + wn * 64 + ni * 32 + c, acc[mi][ni]);
    }
}
#define XCD_LOOP_W(Mt, ntn) const int xcd_ = BIDX() & 7; const int Mx_ = ((Mt) + 7) >> 3; for (int u_ = BIDX() >> 3; u_ < Mx_ * (ntn); u_ += (int)(gridDim.x >> 3))
template <class F>
DI void epi_foreach(f32x16 (&acc)[2][2], int m0, int n0, F f) {
  const int lane = TIDX() & 63, w = TIDX() >> 6, wm = w >> 1, wn = w & 1, hh = lane >> 5, c = lane & 31;
#pragma unroll
  for (int mi = 0; mi < 2; ++mi)
#pragma unroll
    for (int ni = 0; ni < 2; ++ni) f(m0 + wm * 64 + mi * 32 + 4 * hh, n0 + wn * 64 + ni * 32 + c, acc[mi][ni]);
}
DI void tile_map(int u, int Mx, int ntn, int x, int& mt, int& nt) {
  const int sr = u / (8 * ntn);
  const int rows = min(8, Mx - sr * 8);
  const int v = u - sr * 8 * ntn;
  nt = v / rows;
  mt = x * Mx + sr * 8 + (v - nt * rows);
}
#define XCD_LOOP(Mx, ntn) const int xcd_ = BIDX() & 7; for (int u_ = BIDX() >> 3; u_ < (Mx) * (ntn); u_ += (int)(gridDim.x >> 3))
#define EROW(rbase, reg) ((rbase) + ((reg) & 3) + 8 * ((reg) >> 2))

DI void convT(const float* __restrict__ src, int K, int N, h16* __restrict__ dst, float* tile) {
  const int tid = TIDX(), tx = tid & 31, ty = tid >> 5;
  const int tn = N >> 5, nt = (K >> 5) * tn;
  for (int t = BIDX(); t < nt; t += gridDim.x) {
    const int k0 = (t / tn) * 32, n0 = (t % tn) * 32;
#pragma unroll
    for (int i = 0; i < 4; ++i) tile[(ty + 8 * i) * 33 + tx] = src[(size_t)(k0 + ty + 8 * i) * N + n0 + tx];
    __syncthreads();
#pragma unroll
    for (int i = 0; i < 4; ++i) dst[(size_t)(n0 + ty + 8 * i) * K + k0 + tx] = (h16)tile[tx * 33 + ty + 8 * i];
    __syncthreads();
  }
}
DI void conv_weights(const P& p, int l, char* smem) {
  h16* W = (h16*)(p.ws + OFF_W16);
  float* tile = (float*)smem;
  convT(p.in[I_WIN] + (size_t)l * 1024 * 6432, 1024, 6432, W + WO_WIN, tile);
  convT(p.in[I_WUQ] + (size_t)l * 384 * 768, 384, 768, W + WO_UQ, tile);
  convT(p.in[I_WUKV] + (size_t)l * 256 * 1024, 256, 1024, W + WO_UKV, tile);
  convT(p.in[I_G2] + (size_t)l * 128 * 512, 128, 512, W + WO_G2, tile);
  for (int n = 0; n < 3; ++n) convT(p.in[I_WB] + ((size_t)l * 3 + n) * 512 * 1024, 512, 1024, W + WO_WB + (size_t)n * 1024 * 512, tile);
  convT(p.in[I_WOUT] + (size_t)l * 1024 * 1024, 1024, 1024, W + WO_WOUT, tile);
  convT(p.in[I_FIN] + (size_t)l * 1024 * 5632, 1024, 5632, W + WO_FIN, tile);
  convT(p.in[I_FOUT] + (size_t)l * 2816 * 1024, 2816, 1024, W + WO_FOUT, tile);
}

DI void phase_init(const P& p, char* smem) {
  const int tid = TIDX();
  float* mod = (float*)(p.ws + OFF_MOD);
  for (int it = BIDX(); it < 192; it += gridDim.x) {
    const int l = it / 96, n0 = (it % 96) * 64;
    float* s = (float*)smem;
    for (int i = tid; i < 9 * 1024; i += 256) {
      int r = i >> 10, k = i & 1023;
      float v = r < 8 ? p.in[I_C][r * 1024 + k] : p.in[I_CCTX][k];
      s[i] = v / (1.f + expf(-v));
    }
    __syncthreads();
    const int col = tid & 63, kq = tid >> 6;
    float a0 = 0, a1 = 0, a2 = 0, a3 = 0, a4 = 0, a5 = 0, a6 = 0, a7 = 0, a8 = 0;
    const float* wp = p.in[I_ADAW] + (size_t)l * 1024 * 6144 + n0 + col;
    for (int k0 = kq * 256; k0 < kq * 256 + 256; k0 += 16) {
      float wvv[16];
#pragma unroll
      for (int u = 0; u < 16; ++u) wvv[u] = wp[(size_t)(k0 + u) * 6144];
#pragma unroll
      for (int u = 0; u < 16; ++u) {
        const int k = k0 + u;
        const float wv = wvv[u];
        a0 += s[k] * wv; a1 += s[1024 + k] * wv; a2 += s[2048 + k] * wv; a3 += s[3072 + k] * wv; a4 += s[4096 + k] * wv;
        a5 += s[5120 + k] * wv; a6 += s[6144 + k] * wv; a7 += s[7168 + k] * wv; a8 += s[8192 + k] * wv;
      }
    }
    float* red = s + 9 * 1024;
    red[(kq * 9 + 0) * 64 + col] = a0; red[(kq * 9 + 1) * 64 + col] = a1; red[(kq * 9 + 2) * 64 + col] = a2;
    red[(kq * 9 + 3) * 64 + col] = a3; red[(kq * 9 + 4) * 64 + col] = a4; red[(kq * 9 + 5) * 64 + col] = a5;
    red[(kq * 9 + 6) * 64 + col] = a6; red[(kq * 9 + 7) * 64 + col] = a7; red[(kq * 9 + 8) * 64 + col] = a8;
    __syncthreads();
    for (int i = tid; i < 9 * 64; i += 256) {
      int r = i >> 6, cc = i & 63;
      float v = red[(0 * 9 + r) * 64 + cc] + red[(1 * 9 + r) * 64 + cc] + red[(2 * 9 + r) * 64 + cc] + red[(3 * 9 + r) * 64 + cc];
      mod[((size_t)l * 9 + r) * 6144 + n0 + cc] = v + p.in[I_ADAB][(size_t)l * 6144 + n0 + cc];
    }
    __syncthreads();
  }
  f32x2* rm = (f32x2*)(p.ws + OFF_ROPEM);
  f32x2* rg = (f32x2*)(p.ws + OFF_ROPEG);
  for (int i = BIDX() * 256 + tid; i < 4096 * 48; i += gridDim.x * 256) {
    int t = i / 48, j = i % 48;
    float rowi = (float)(t >> 6), coli = (float)(t & 63);
    if (j < 16) {
      int q = j & 7;
      float f = exp2f(-(float)q / 8.f * 13.287712379549449f);
      float ang = (j < 8 ? rowi : coli) * f;
      f32x2 cs; cs.x = cosf(ang); cs.y = sinf(ang);
      rm[t * 16 + j] = cs;
    } else {
      int jj = j - 16, q = jj & 15;
      float f = exp2f(-(float)q / 16.f * 13.287712379549449f);
      float ang = (jj < 16 ? rowi : coli) * f;
      f32x2 cs; cs.x = cosf(ang); cs.y = sinf(ang);
      rg[t * 32 + jj] = cs;
    }
  }
  if (BIDX() == 0 && TIDX() < 64) ((int*)(p.ws + OFF_CTR))[TIDX()] = 0;
  conv_weights(p, 0, smem);
}

DI void rows_norm_mod(const P& p, const float* xlat, const float* xctx, int l, const float* gain, int sh_idx, int sc_idx,
                      h16* dst, int nrows) {
  const int lane = TIDX() & 63;
  const int gw = BIDX() * 4 + (TIDX() >> 6), nw = gridDim.x * 4;
  const float* mod = (const float*)(p.ws + OFF_MOD);
  for (int row = gw; row < nrows; row += nw) {
    const float* xr = row < TL ? xlat + (size_t)row * 1024 : xctx + (size_t)(row - TL) * 1024;
    const int mrow = row < TL ? (row >> 12) : 8;
    const float* mr = mod + ((size_t)l * 9 + mrow) * 6144;
    f32x4 v[4];
    float ss = 0.f;
#pragma unroll
    for (int i = 0; i < 4; ++i) {
      v[i] = *(const f32x4*)(xr + lane * 4 + 256 * i);
      ss += v[i].x * v[i].x + v[i].y * v[i].y + v[i].z * v[i].z + v[i].w * v[i].w;
    }
    ss = wave_sum(ss);
    const float rstd = rsqrtf(ss * (1.f / 1024.f) + EPS);
#pragma unroll
    for (int i = 0; i < 4; ++i) {
      const int c = lane * 4 + 256 * i;
      f32x4 g = *(const f32x4*)(gain + c), sc = *(const f32x4*)(mr + sc_idx * 1024 + c), sh = *(const f32x4*)(mr + sh_idx * 1024 + c);
      h16x4 o;
      o.x = (h16)(v[i].x * rstd * g.x * (1.f + sc.x) + sh.x);
      o.y = (h16)(v[i].y * rstd * g.y * (1.f + sc.y) + sh.y);
      o.z = (h16)(v[i].z * rstd * g.z * (1.f + sc.z) + sh.z);
      o.w = (h16)(v[i].w * rstd * g.w * (1.f + sc.w) + sh.w);
      *(h16x4*)(dst + (size_t)row * 1024 + c) = o;
    }
  }
}

DI void rows_resid_norm(const P& p, const float* xlat, const float* xctx, const h16* y, int l, int gate_idx, const float* post_g,
                        bool do_next, int l2, const float* gain2, int sh_idx, int sc_idx, h16* dst, int nrows) {
  const int lane = TIDX() & 63;
  const int gw = BIDX() * 4 + (TIDX() >> 6), nw = gridDim.x * 4;
  const float* mod = (const float*)(p.ws + OFF_MOD);
  float* xc = (float*)(p.ws + OFF_XC);
  for (int row = gw; row < nrows; row += nw) {
    const float* xr = row < TL ? xlat + (size_t)row * 1024 : xctx + (size_t)(row - TL) * 1024;
    float* xo = row < TL ? p.out + (size_t)row * 1024 : xc + (size_t)(row - TL) * 1024;
    const int mrow = row < TL ? (row >> 12) : 8;
    const float* mr = mod + ((size_t)l * 9 + mrow) * 6144;
    const float* mr2 = mod + ((size_t)l2 * 9 + mrow) * 6144;
    f32x4 yv[4], xv[4];
    float ss = 0.f;
#pragma unroll
    for (int i = 0; i < 4; ++i) {
      h16x4 t = *(const h16x4*)(y + (size_t)row * 1024 + lane * 4 + 256 * i);
      yv[i].x = (float)t.x; yv[i].y = (float)t.y; yv[i].z = (float)t.z; yv[i].w = (float)t.w;
      ss += yv[i].x * yv[i].x + yv[i].y * yv[i].y + yv[i].z * yv[i].z + yv[i].w * yv[i].w;
      xv[i] = *(const f32x4*)(xr + lane * 4 + 256 * i);
    }
    ss = wave_sum(ss);
    const float rstd = rsqrtf(ss * (1.f / 1024.f) + EPS);
    float s2 = 0.f;
#pragma unroll
    for (int i = 0; i < 4; ++i) {
      const int c = lane * 4 + 256 * i;
      f32x4 g = *(const f32x4*)(post_g + c), gt = *(const f32x4*)(mr + gate_idx * 1024 + c);
      xv[i].x += gt.x * (yv[i].x * rstd * g.x);
      xv[i].y += gt.y * (yv[i].y * rstd * g.y);
      xv[i].z += gt.z * (yv[i].z * rstd * g.z);
      xv[i].w += gt.w * (yv[i].w * rstd * g.w);
      *(f32x4*)(xo + c) = xv[i];
      s2 += xv[i].x * xv[i].x + xv[i].y * xv[i].y + xv[i].z * xv[i].z + xv[i].w * xv[i].w;
    }
    if (do_next) {
      s2 = wave_sum(s2);
      const float r2 = rsqrtf(s2 * (1.f / 1024.f) + EPS);
#pragma unroll
      for (int i = 0; i < 4; ++i) {
        const int c = lane * 4 + 256 * i;
        f32x4 g = *(const f32x4*)(gain2 + c), sc = *(const f32x4*)(mr2 + sc_idx * 1024 + c), sh = *(const f32x4*)(mr2 + sh_idx * 1024 + c);
        h16x4 o;
        o.x = (h16)(xv[i].x * r2 * g.x * (1.f + sc.x) + sh.x);
        o.y = (h16)(xv[i].y * r2 * g.y * (1.f + sc.y) + sh.y);
        o.z = (h16)(xv[i].z * r2 * g.z * (1.f + sc.z) + sh.z);
        o.w = (h16)(xv[i].w * r2 * g.w * (1.f + sc.w) + sh.w);
        *(h16x4*)(dst + (size_t)row * 1024 + c) = o;
      }
    }
  }
}

DI void phase_proj(const P& p, int l, char* smem) {
  const h16* W = (const h16*)(p.ws + OFF_W16) + WO_WIN;
  const h16* hbuf = (const h16*)(p.ws + OFF_HB);
  h16* cqkv = (h16*)(p.ws + OFF_X);
  h16* krot = (h16*)(p.ws + OFF_KROT);
  h16* Qg = (h16*)(p.ws + OFF_QG);
  h16* Kg = (h16*)(p.ws + OFF_KG);
  h16* VgT = (h16*)(p.ws + OFF_VGT);
  h16* rkv = (h16*)(p.ws + OFF_R1);
  h16* lora = rkv + (size_t)TA * 1536;
  XCD_LOOP_W(136, 27) {
    int mt_, nt_;
    tile_map(u_, Mx_, 27, xcd_, mt_, nt_);
    if (mt_ >= 136) continue;
    const int m0 = mt_ * 256, n0 = nt_ * 128;
    f32x16 acc[4][2];
    zero_acc_w(acc);
    gemm_tile_w(hbuf + (size_t)m0 * 1024, 1024, W, 1024, [&](int rr) { return n0 + rr; }, 1024, acc, (h16*)smem);
    epi_foreach_w(acc, m0, n0, [&](int rbase, int n, const f32x16& v) {
      const int nb = n & ~31;
      if (nb >= 3360) return;
      const int b = rbase < TL ? (rbase >> 12) : ((rbase - TL) >> 8);
      const int srb = srow_of(rbase);
      if (nb < 640) {
#pragma unroll
        for (int i = 0; i < 16; ++i) cqkv[(size_t)EROW(rbase, i) * 640 + n] = (h16)v[i];
      } else if (nb < 672) {
#pragma unroll
        for (int i = 0; i < 16; ++i) krot[(size_t)EROW(srb, i) * 32 + (n - 640)] = (h16)v[i];
      } else if (nb < 1184) {
        const int hq = (n - 672) >> 6, d = (n - 672) & 63;
        h16* q = Qg + (size_t)hq * SA * 64 + d;
#pragma unroll
        for (int i = 0; i < 16; ++i) q[((size_t)EROW(srb, i) + (size_t)b * 7 * SA) * 64] = (h16)v[i];
      } else if (nb < 1312) {
        const int kh = (n - 1184) >> 6, d = (n - 1184) & 63;
        h16* k = Kg + (size_t)kh * SA * 64 + d;
#pragma unroll
        for (int i = 0; i < 16; ++i) k[((size_t)EROW(srb, i) + (size_t)b * SA) * 64] = (h16)v[i];
      } else if (nb < 1440) {
        const int kh = (n - 1312) >> 6, d = (n - 1312) & 63;
        const int s = srb - b * SA;
        h16* vt = VgT + ((size_t)(b * 2 + kh) * 64 + d) * SA + s;
#pragma unroll
        for (int g = 0; g < 4; ++g) {
          h16x4 o; o.x = (h16)v[4 * g]; o.y = (h16)v[4 * g + 1]; o.z = (h16)v[4 * g + 2]; o.w = (h16)v[4 * g + 3];
          *(h16x4*)(vt + 8 * g) = o;
        }
      } else if (nb < 2976) {
#pragma unroll
        for (int i = 0; i < 16; ++i) rkv[(size_t)EROW(rbase, i) * 1536 + (n - 1440)] = (h16)v[i];
      } else {
        const int j = n - 2976;
#pragma unroll
        for (int i = 0; i < 16; ++i) {
          float x = v[i];
          if (j < 128) x = tanhf(x);
          else if (j >= 256) x = sigmoidf_(x);
          lora[(size_t)EROW(rbase, i) * 384 + j] = (h16)x;
        }
      }
    });
  }
}

DI void phase_prep(const P& p, int l, int boff, int geff) {
  const int lane = TIDX() & 63;
  const int gw = (BIDX() - boff) * 4 + (TIDX() >> 6), nw = geff * 4;
  h16* cqkv = (h16*)(p.ws + OFF_X);
  h16* krot = (h16*)(p.ws + OFF_KROT);
  h16* Qg = (h16*)(p.ws + OFF_QG);
  h16* Kg = (h16*)(p.ws + OFF_KG);
  const f32x2* rm = (const f32x2*)(p.ws + OFF_ROPEM);
  const f32x2* rg = (const f32x2*)(p.ws + OFF_ROPEG);
  const float* qn = p.in[I_QNORM] + l * 384;
  const float* kvn = p.in[I_KVNORM] + l * 256;
  const float gq = p.in[I_GQN][l * 64 + lane], gk = p.in[I_GKN][l * 64 + lane];
  for (int row = gw; row < TA; row += nw) {
    const bool lat = row < TL;
    const int b = lat ? (row >> 12) : ((row - TL) >> 8);
    const int srow = srow_of(row);
    const int tpos = row & 4095;
    {
      h16* cq = cqkv + (size_t)row * 640;
      float x[6], ss = 0.f;
#pragma unroll
      for (int i = 0; i < 6; ++i) { x[i] = (float)cq[lane + 64 * i]; ss += x[i] * x[i]; }
      ss = wave_sum(ss);
      float rstd = rsqrtf(ss * (1.f / 384.f) + EPS);
#pragma unroll
      for (int i = 0; i < 6; ++i) cq[lane + 64 * i] = (h16)(x[i] * rstd * qn[lane + 64 * i]);
      h16* ck = cq + 384;
      float y[4]; ss = 0.f;
#pragma unroll
      for (int i = 0; i < 4; ++i) { y[i] = (float)ck[lane + 64 * i]; ss += y[i] * y[i]; }
      ss = wave_sum(ss);
      rstd = rsqrtf(ss * (1.f / 256.f) + EPS);
#pragma unroll
      for (int i = 0; i < 4; ++i) ck[lane + 64 * i] = (h16)(y[i] * rstd * kvn[lane + 64 * i]);
    }
    if (lat && lane < 16) {
      h16* kr = krot + (size_t)srow * 32;
      float x1 = (float)kr[lane], x2 = (float)kr[lane + 16];
      f32x2 cs = rm[tpos * 16 + lane];
      kr[lane] = (h16)(x1 * cs.x - x2 * cs.y);
      kr[lane + 16] = (h16)(x1 * cs.y + x2 * cs.x);
    }
    f32x2 cs; cs.x = 1.f; cs.y = 0.f;
    if (lat) cs = rg[tpos * 32 + (lane & 31)];
#pragma unroll
    for (int hq = 0; hq < 8; ++hq) {
      h16* q = Qg + ((size_t)(b * 8 + hq) * SA + (srow - b * SA)) * 64;
      float x = (float)q[lane];
      float ss = wave_sum(x * x);
      x = x * rsqrtf(ss * (1.f / 64.f) + EPS) * gq;
      float o = shx(x, 32);
      float rr = lane < 32 ? (x * cs.x - o * cs.y) : (o * cs.y + x * cs.x);
      q[lane] = (h16)(rr * (0.125f * LOG2E));
    }
#pragma unroll
    for (int kh = 0; kh < 2; ++kh) {
      h16* k = Kg + ((size_t)(b * 2 + kh) * SA + (srow - b * SA)) * 64;
      float x = (float)k[lane];
      float ss = wave_sum(x * x);
      x = x * rsqrtf(ss * (1.f / 64.f) + EPS) * gk;
      float o = shx(x, 32);
      float rr = lane < 32 ? (x * cs.x - o * cs.y) : (o * cs.y + x * cs.x);
      k[lane] = (h16)rr;
    }
  }
}

DI void phase_uproj(const P& p, int l, char* smem, int boff, int geff) {
  const h16* W = (const h16*)(p.ws + OFF_W16);
  const h16* cqkv = (const h16*)(p.ws + OFF_X);
  h16* Qm = (h16*)(p.ws + OFF_QM);
  h16* kn = (h16*)(p.ws + OFF_KN);
  h16* VmT = (h16*)(p.ws + OFF_VMT);
  const f32x2* rm = (const f32x2*)(p.ws + OFF_ROPEM);
  const float qscale = 0.10206207261596575f * LOG2E;
  const int be_ = BIDX() - boff;
  const int xcd_ = be_ & 7;
  const int Mx_ = (136 + 7) >> 3;
  for (int u_ = be_ >> 3; u_ < Mx_ * 14; u_ += (geff >> 3)) {
    int mt_, nn;
    tile_map(u_, Mx_, 14, xcd_, mt_, nn);
    if (mt_ >= 136) continue;
    const int m0 = mt_ * 256;
    f32x16 acc[4][2];
    zero_acc_w(acc);
    if (nn < 6) {
      const int n0 = nn * 128;
      gemm_tile_w(cqkv + (size_t)m0 * 640, 640, W + WO_UQ, 384, [&](int rr) { return n0 + rr; }, 384, acc, (h16*)smem);
      epi_foreach_w(acc, m0, n0, [&](int rbase, int n, const f32x16& v) {
        const int b = rbase < TL ? (rbase >> 12) : ((rbase - TL) >> 8);
        const int srb = srow_of(rbase);
        const int head = n / 96, dd = n - head * 96;
        h16* q = Qm + ((size_t)(b * 7 + head) * SA) * 96 + dd;
        if (dd < 64 || rbase >= TL) {
#pragma unroll
          for (int i = 0; i < 16; ++i) q[(size_t)EROW(srb, i) * 96] = (h16)(v[i] * qscale);
        } else {
          const int ii = dd - 64;
#pragma unroll
          for (int i = 0; i < 16; ++i) {
            float x = v[i];
            float o = shx(x, 16);
            f32x2 cs = rm[(EROW(rbase, i) & 4095) * 16 + (ii & 15)];
            float rr = ii < 16 ? (x * cs.x - o * cs.y) : (o * cs.y + x * cs.x);
            q[(size_t)EROW(srb, i) * 96] = (h16)(rr * qscale);
          }
        }
      });
    } else {
      const int n0 = (nn - 6) * 128;
      gemm_tile_w(cqkv + (size_t)m0 * 640 + 384, 640, W + WO_UKV, 256, [&](int rr) { return n0 + rr; }, 256, acc, (h16*)smem);
      epi_foreach_w(acc, m0, n0, [&](int rbase, int n, const f32x16& v) {
        const int b = rbase < TL ? (rbase >> 12) : ((rbase - TL) >> 8);
        const int srb = srow_of(rbase);
        const int head = n >> 7, dd = n & 127;
        if (dd < 64) {
          h16* k = kn + ((size_t)(b * 7 + head) * SA) * 64 + dd;
#pragma unroll
          for (int i = 0; i < 16; ++i) k[(size_t)EROW(srb, i) * 64] = (h16)v[i];
        } else {
          const int s = srb - b * SA;
          h16* vt = VmT + ((size_t)(b * 8 + head) * 64 + (dd - 64)) * SA + s;
#pragma unroll
          for (int g = 0; g < 4; ++g) {
            h16x4 o; o.x = (h16)v[4 * g]; o.y = (h16)v[4 * g + 1]; o.z = (h16)v[4 * g + 2]; o.w = (h16)v[4 * g + 3];
            *(h16x4*)(vt + 8 * g) = o;
          }
        }
      });
    }
  }
}

template <int DK, bool MLA>
DI void attn_item(const h16* __restrict__ Q, const h16* __restrict__ Kp, const h16* __restrict__ Kr, const h16* __restrict__ Vt,
                  int kbeg, int kend, h16* __restrict__ out, h16* sm) {
  constexpr int KS = DK + 8;
  constexpr int NKC = DK / 8;
  constexpr int NCH = 64 * NKC / 256;
  constexpr int BUF = 64 * KS + 64 * 72;
  const int tid = TIDX(), lane = tid & 63, w = tid >> 6, r = lane & 31, hh = lane >> 5;
  h16x8 qf[DK / 16];
  {
    const h16* qr = Q + (size_t)(w * 32 + r) * DK + hh * 8;
#pragma unroll
    for (int ks = 0; ks < DK / 16; ++ks) qf[ks] = *(const h16x8*)(qr + ks * 16);
  }
  f32x16 ot[2];
#pragma unroll
  for (int i = 0; i < 16; ++i) { ot[0][i] = 0.f; ot[1][i] = 0.f; }
  float m = -1000.f, lsum = 0.f;
  u32x4 rk[NCH], rv[2];
  auto gload = [&](int kb) {
#pragma unroll
    for (int i = 0; i < NCH; ++i) {
      const int c = tid + 256 * i, key = c / NKC, part = c % NKC;
      if (MLA) {
        if (part < 8) rk[i] = *(const u32x4*)(Kp + (size_t)(kb + key) * 64 + part * 8);
        else rk[i] = *(const u32x4*)(Kr + (size_t)(kb + key) * 32 + (part - 8) * 8);
      } else {
        rk[i] = *(const u32x4*)(Kp + (size_t)(kb + key) * 64 + part * 8);
      }
    }
#pragma unroll
    for (int i = 0; i < 2; ++i) {
      const int c = tid + 256 * i, dv = c >> 3, kc = c & 7;
      rv[i] = *(const u32x4*)(Vt + (size_t)dv * SA + kb + kc * 8);
    }
  };
  gload(kbeg);
  const int ntile = (kend - kbeg) >> 6;
  for (int it = 0; it < ntile; ++it) {
    h16* ksm = sm + (it & 1) * BUF;
    h16* vsm = ksm + 64 * KS;
#pragma unroll
    for (int i = 0; i < NCH; ++i) {
      const int c = tid + 256 * i, key = c / NKC, part = c % NKC;
      *(u32x4*)(ksm + key * KS + part * 8) = rk[i];
    }
#pragma unroll
    for (int i = 0; i < 2; ++i) {
      const int c = tid + 256 * i, dv = c >> 3, kc = c & 7;
      *(u32x4*)(vsm + dv * 72 + kc * 8) = rv[i];
    }
    __syncthreads();
    if (it + 1 < ntile) gload(kbeg + (it + 1) * 64);
    f32x16 st[2];
    const float negm = -m;
#pragma unroll
    for (int i = 0; i < 16; ++i) { st[0][i] = negm; st[1][i] = negm; }
#pragma unroll
    for (int ks = 0; ks < DK / 16; ++ks) {
      h16x8 k0 = *(const h16x8*)(ksm + r * KS + ks * 16 + hh * 8);
      h16x8 k1 = *(const h16x8*)(ksm + (32 + r) * KS + ks * 16 + hh * 8);
      st[0] = MFMA(k0, qf[ks], st[0]);
      st[1] = MFMA(k1, qf[ks], st[1]);
    }
    float mx = fmaxf(st[0][0], st[1][0]);
#pragma unroll
    for (int i = 1; i < 16; ++i) mx = fmaxf(mx, fmaxf(st[0][i], st[1][i]));
    mx = x32_max(mx);
    if (__builtin_amdgcn_ballot_w64(mx > 8.f) != 0) {
      const float dlt = fmaxf(mx, 0.f);
      const float alpha = __builtin_amdgcn_exp2f(-dlt);
      m += dlt;
      lsum *= alpha;
#pragma unroll
      for (int i = 0; i < 16; ++i) { ot[0][i] *= alpha; ot[1][i] *= alpha; st[0][i] -= dlt; st[1][i] -= dlt; }
    }
    float ps = 0.f;
#pragma unroll
    for (int i = 0; i < 16; ++i) {
      st[0][i] = __builtin_amdgcn_exp2f(st[0][i]);
      st[1][i] = __builtin_amdgcn_exp2f(st[1][i]);
      ps += st[0][i] + st[1][i];
    }
    lsum += ps;
#pragma unroll
    for (int s4 = 0; s4 < 4; ++s4) {
      const int kt2 = s4 >> 1, hf = s4 & 1;
      h16x8 pb;
#pragma unroll
      for (int j = 0; j < 8; ++j) pb[j] = (h16)st[kt2][8 * hf + j];
      const int kb = kt2 * 32 + 16 * hf;
#pragma unroll
      for (int dt = 0; dt < 2; ++dt) {
        const h16* vp = vsm + (dt * 32 + r) * 72 + kb + 4 * hh;
        h16x4 lo = *(const h16x4*)vp, hi = *(const h16x4*)(vp + 8);
        h16x8 va = __builtin_shufflevector(lo, hi, 0, 1, 2, 3, 4, 5, 6, 7);
        ot[dt] = MFMA(va, pb, ot[dt]);
      }
    }
  }
  __syncthreads();
  lsum = x32_sum(lsum);
  const float inv = 1.f / lsum;
  h16* orow = out + (size_t)(w * 32 + r) * 512;
#pragma unroll
  for (int dt = 0; dt < 2; ++dt)
#pragma unroll
    for (int g = 0; g < 4; ++g) {
      h16x4 o;
      o.x = (h16)(ot[dt][4 * g] * inv); o.y = (h16)(ot[dt][4 * g + 1] * inv);
      o.z = (h16)(ot[dt][4 * g + 2] * inv); o.w = (h16)(ot[dt][4 * g + 3] * inv);
      *(h16x4*)(orow + dt * 32 + 8 * g + 4 * hh) = o;
    }
}

DI void attn_dispatch(const P& p, int b, int it, char* smem) {
  const h16* Qm = (const h16*)(p.ws + OFF_QM);
  const h16* kn = (const h16*)(p.ws + OFF_KN);
  const h16* krot = (const h16*)(p.ws + OFF_KROT);
  const h16* VmT = (const h16*)(p.ws + OFF_VMT);
  const h16* Qg = (const h16*)(p.ws + OFF_QG);
  const h16* Kg = (const h16*)(p.ws + OFF_KG);
  const h16* VgT = (const h16*)(p.ws + OFF_VGT);
  h16* oa = (h16*)(p.ws + OFF_X);
  h16* ob = oa + (size_t)TA * 512;
  bool mla; int head, s0, kbeg, kend; size_t row0;
  if (it < 512) {
    mla = it < 256;
    head = (it >> 5) & 7; s0 = (it & 31) * 128; kbeg = 0; kend = SA;
    row0 = (size_t)b * 4096 + s0;
  } else {
    const int j = it - 512;
    mla = j < 16;
    head = (j >> 1) & 7; const int qb = j & 1;
    s0 = 4096 + qb * 128; kbeg = 4096; kend = SA;
    row0 = (size_t)TL + b * 256 + qb * 128;
  }
  if (mla) {
    attn_item<96, true>(Qm + ((size_t)(b * 8 + head) * SA + s0) * 96, kn + (size_t)(b * 8 + head) * SA * 64, krot + (size_t)b * SA * 32,
                        VmT + (size_t)(b * 8 + head) * 64 * SA, kbeg, kend, oa + row0 * 512 + head * 64, (h16*)smem);
  } else {
    attn_item<64, false>(Qg + ((size_t)(b * 8 + head) * SA + s0) * 64, Kg + (size_t)(b * 2 + (head >> 2)) * SA * 64, nullptr,
                         VgT + (size_t)(b * 2 + (head >> 2)) * 64 * SA, kbeg, kend, ob + row0 * 512 + head * 64, (h16*)smem);
  }
}
DI void scan_chain(const P& p, int l, int chain, int half, char* smem) {
  const int tid = TIDX(), lane = tid & 63, w = tid >> 6;
  const int d = chain >> 6, b = (chain >> 3) & 7, h = chain & 7;
  float* raw = (float*)smem;
  float* ckk = raw + 4096;
  float* cw = ckk + 2048; float* cb = cw + 2048; float* ck = cb + 2048; float* cr = ck + 2048; float* cv = cr + 2048;
  const h16* rkv = (const h16*)(p.ws + OFF_R1);
  const h16* lora = rkv + (size_t)TA * 1536;
  float* bs = (float*)(p.ws + OFF_BS);
  h16* so = (h16*)(p.ws + OFF_HB) + (size_t)d * TA * 512;
  const int mat = w & 1, nblk = w >> 1;
  h16x8 bf[4];
  {
    const float* wsrc = (mat ? p.in[I_A2] : p.in[I_W2]) + ((size_t)(l * 2 + d) * 64) * 512 + h * 64 + nblk * 32 + (lane & 31);
#pragma unroll
    for (int ks = 0; ks < 4; ++ks)
#pragma unroll
      for (int e = 0; e < 8; ++e) bf[ks][e] = (h16)wsrc[(size_t)(ks * 16 + 8 * (lane >> 5) + e) * 512];
  }
  const int c = h * 64 + lane;
  const float w0 = p.in[I_W0][(l * 2 + d) * 512 + c], a0 = p.in[I_A0][(l * 2 + d) * 512 + c];
  const float kkc = p.in[I_KK][l * 512 + c], kac = p.in[I_KA][l * 512 + c], rkc = p.in[I_RK][l * 512 + c];
  const float* cvp = p.in[I_CONV] + (size_t)l * 3 * 1536;
  const float trA = cvp[(d ? 3072 : 0) + c], tr1 = cvp[1536 + c], trC = cvp[(d ? 0 : 3072) + c];
  const float tkA = cvp[(d ? 3072 : 0) + 512 + c], tk1 = cvp[1536 + 512 + c], tkC = cvp[(d ? 0 : 3072) + 512 + c];
  const float tvA = cvp[(d ? 3072 : 0) + 1024 + c], tv1 = cvp[1536 + 1024 + c], tvC = cvp[(d ? 0 : 3072) + 1024 + c];
  f32x2 S[2][2];
#pragma unroll
  for (int e = 0; e < 2; ++e) { S[e][0].x = 0.f; S[e][0].y = 0.f; S[e][1].x = 0.f; S[e][1].y = 0.f; }
  const int rg = lane >> 4, jq = lane & 15;
  auto row16_sum = [](float v) -> float {
    v += __int_as_float(__builtin_amdgcn_mov_dpp(__float_as_int(v), 0xB1, 0xF, 0xF, true));
    v += __int_as_float(__builtin_amdgcn_mov_dpp(__float_as_int(v), 0x4E, 0xF, 0xF, true));
    v += __int_as_float(__builtin_amdgcn_mov_dpp(__float_as_int(v), 0x141, 0xF, 0xF, true));
    v += __int_as_float(__builtin_amdgcn_mov_dpp(__float_as_int(v), 0x140, 0xF, 0xF, true));
    return v;
  };
  h16 xr[10], xk[10], xv[10];
  u32x4 af[4];
  auto prefetch = [&](int n0) {
    const bool lat = n0 >= 256;
    const int L = lat ? 4096 : 256;
    const int rowbase = lat ? b * 4096 : TL + b * 256;
    const int nn = (lat ? n0 - 256 : n0);
    const int P0 = d ? (L - 1 - (nn + 8 * w)) : (nn + 8 * w);
#pragma unroll
    for (int q = 0; q < 10; ++q) {
      const int pq = d ? (P0 + 1 - q) : (P0 - 1 + q);
      h16 a_ = (h16)0.f, b_ = (h16)0.f, c_ = (h16)0.f;
      if (pq >= 0 && pq < L) {
        const h16* x1 = rkv + (size_t)(rowbase + pq) * 1536 + c;
        a_ = x1[0]; b_ = x1[512]; c_ = x1[1024];
      }
      xr[q] = a_; xk[q] = b_; xv[q] = c_;
    }
    const int nt = nn + (lane & 31);
    const int pt = d ? (L - 1 - nt) : nt;
    const h16* lp = lora + (size_t)(rowbase + pt) * 384 + mat * 128 + d * 64 + 8 * (lane >> 5);
#pragma unroll
    for (int ks = 0; ks < 4; ++ks) af[ks] = *(const u32x4*)(lp + ks * 16);
  };
  prefetch(0);
  __syncthreads();
  for (int n0 = 0; n0 < 256 + 4096; n0 += 32) {
    const bool lat = n0 >= 256;
    const int L = lat ? 4096 : 256;
    const int rowbase = lat ? b * 4096 : TL + b * 256;
    const int nn = (lat ? n0 - 256 : n0);
    {
      f32x16 acc;
#pragma unroll
      for (int i = 0; i < 16; ++i) acc[i] = 0.f;
#pragma unroll
      for (int ks = 0; ks < 4; ++ks) acc = MFMA(__builtin_bit_cast(h16x8, af[ks]), bf[ks], acc);
      float* rw = raw + mat * 2048 + nblk * 32 + (lane & 31);
#pragma unroll
      for (int i = 0; i < 16; ++i) rw[(4 * (lane >> 5) + (i & 3) + 8 * (i >> 2)) * 64] = acc[i];
    }
    __syncthreads();
#pragma unroll
    for (int e = 0; e < 8; ++e) {
      const int tt = 8 * w + e;
      const int n = nn + tt;
      const int pos = d ? (L - 1 - n) : n;
      const size_t row = (size_t)rowbase + pos;
      const float rr = trA * (float)xr[e] + tr1 * (float)xr[e + 1] + trC * (float)xr[e + 2];
      const float kx = tkA * (float)xk[e] + tk1 * (float)xk[e + 1] + tkC * (float)xk[e + 2];
      const float vv = tvA * (float)xv[e] + tv1 * (float)xv[e + 1] + tvC * (float)xv[e + 2];
      const float wr = w0 + raw[tt * 64 + lane], ar = a0 + raw[2048 + tt * 64 + lane];
      const float z = -wr;
      const float sp = fmaxf(z, 0.f) + __logf(1.f + __expf(-fabsf(z)));
      const float dec = __expf(-__expf(-sp - 0.5f));
      const float aa = sigmoidf_(ar);
      const float kkr = kx * kkc;
      const float kkn = kkr * __builtin_amdgcn_rsqf(fmaxf(wave_sum(kkr * kkr), 1e-24f));
      const float km = kx * (1.f + (aa - 1.f) * kac);
      const float bon = wave_sum(rr * km * rkc);
      if (lane == 0) bs[((size_t)d * TA + row) * 8 + h] = bon;
      ckk[tt * 64 + lane] = kkn; cw[tt * 64 + lane] = dec; cb[tt * 64 + lane] = kkn * aa;
      ck[tt * 64 + lane] = km; cr[tt * 64 + lane] = rr; cv[tt * 64 + lane] = vv;
    }
    __syncthreads();
    if (n0 + 32 < 256 + 4096) prefetch(n0 + 32);
    {
      const float* base = ckk + jq * 4;
      const float* vbase = cv + half * 32 + w * 8 + rg * 2;
      h16* sobase = so + (size_t)rowbase * 512 + h * 64 + half * 32 + w * 8 + rg * 2;
      f32x4 kkA, wwA, bbA, kmA, rrA, kkB, wwB, bbB, kmB, rrB;
      f32x2 vvA, vvB;
#define SCAN_LD(tt, kk, ww, bb, km, rr, vv)                                                              \
  kk = *(const f32x4*)(base + (tt) * 64); ww = *(const f32x4*)(base + 2048 + (tt) * 64);                 \
  bb = *(const f32x4*)(base + 4096 + (tt) * 64); km = *(const f32x4*)(base + 6144 + (tt) * 64);          \
  rr = *(const f32x4*)(base + 8192 + (tt) * 64); vv = *(const f32x2*)(vbase + (tt) * 64);
#define SCAN_STEP(tt, kk, ww, bb, km, rr, vv)                                                            \
  {                                                                                                      \
    f32x2 klo, khi, wlo, whi, blo, bhi, mlo, mhi, rlo, rhi;                                              \
    klo.x = kk.x; klo.y = kk.y; khi.x = kk.z; khi.y = kk.w; wlo.x = ww.x; wlo.y = ww.y; whi.x = ww.z; whi.y = ww.w; \
    blo.x = bb.x; blo.y = bb.y; bhi.x = bb.z; bhi.y = bb.w; mlo.x = km.x; mlo.y = km.y; mhi.x = km.z; mhi.y = km.w; \
    rlo.x = rr.x; rlo.y = rr.y; rhi.x = rr.z; rhi.y = rr.w;                                              \
    float sa_[2], y_[2];                                                                                 \
    _Pragma("unroll") for (int e = 0; e < 2; ++e) {                                                      \
      f32x2 t2 = S[e][0] * klo; t2 += S[e][1] * khi;                                                     \
      sa_[e] = -row16_sum(t2.x + t2.y);                                                                  \
    }                                                                                                    \
    _Pragma("unroll") for (int e = 0; e < 2; ++e) {                                                      \
      f32x2 sav; sav.x = sa_[e]; sav.y = sa_[e];                                                         \
      f32x2 vev; vev.x = vv[e]; vev.y = vv[e];                                                           \
      S[e][0] = S[e][0] * wlo; S[e][0] += sav * blo; S[e][0] += vev * mlo;                               \
      S[e][1] = S[e][1] * whi; S[e][1] += sav * bhi; S[e][1] += vev * mhi;                               \
      f32x2 t2 = S[e][0] * rlo; t2 += S[e][1] * rhi;                                                     \
      y_[e] = row16_sum(t2.x + t2.y);                                                                    \
    }                                                                                                    \
    if (jq == 0) {                                                                                       \
      const int n_ = nn + (tt);                                                                          \
      const int pos_ = d ? (L - 1 - n_) : n_;                                                            \
      h16x2 o_; o_.x = (h16)y_[0]; o_.y = (h16)y_[1];                                                    \
      *(h16x2*)(sobase + (size_t)pos_ * 512) = o_;                                                       \
    }                                                                                                    \
  }
      SCAN_LD(0, kkA, wwA, bbA, kmA, rrA, vvA)
#pragma unroll 1
      for (int tt = 0; tt < 32; tt += 2) {
        SCAN_LD(tt + 1, kkB, wwB, bbB, kmB, rrB, vvB)
        SCAN_STEP(tt, kkA, wwA, bbA, kmA, rrA, vvA)
        if (tt + 2 < 32) { SCAN_LD(tt + 2, kkA, wwA, bbA, kmA, rrA, vvA) }
        SCAN_STEP(tt + 1, kkB, wwB, bbB, kmB, rrB, vvB)
      }
#undef SCAN_LD
#undef SCAN_STEP
    }
  }
  __syncthreads();
}
DI void scan_chain_c(const P& p, int l, int chain, char* smem, const XcdBarrier* xb, const int* hint, int nhs) {
  const int tid = TIDX(), lane = tid & 63, w = tid >> 6, r = lane & 31, hh = lane >> 5;
  const int d = chain >> 6, b = (chain >> 3) & 7, h = chain & 7;
  float* raw = (float*)smem;
  float* GT = (float*)smem;
  b16* UTt = (b16*)(smem + 8192);
  float* tot = (float*)(smem + 16384);
  b16* Qt = (b16*)(smem + 17408);
  b16* Rt = (b16*)(smem + 22016);
  b16* Bt = (b16*)(smem + 26624);
  b16* Kt = (b16*)(smem + 31232);
  b16* BgT = (b16*)(smem + 35840);
  b16* KgT = (b16*)(smem + 40960);
  b16* VT = (b16*)(smem + 46080);
  b16* Sl = (b16*)(smem + 51200);
  float* Am = (float*)(smem + 60416);
  b16* Bm = (b16*)(smem + 65024);
  b16* A2 = (b16*)(smem + 67584);
  b16* B2 = (b16*)(smem + 70144);
  float* GL = (float*)(smem + 72704);
  const h16* rkv = (const h16*)(p.ws + OFF_R1);
  const h16* lora = rkv + (size_t)TA * 1536;
  float* bs = (float*)(p.ws + OFF_BS);
  h16* so = (h16*)(p.ws + OFF_HB) + (size_t)d * TA * 512;
  const int mat = w & 1, nblk = w >> 1;
  h16x8 bf[4];
  {
    const float* wsrc = (mat ? p.in[I_A2] : p.in[I_W2]) + ((size_t)(l * 2 + d) * 64) * 512 + h * 64 + nblk * 32 + r;
#pragma unroll
    for (int ks = 0; ks < 4; ++ks)
#pragma unroll
      for (int e = 0; e < 8; ++e) bf[ks][e] = (h16)wsrc[(size_t)(ks * 16 + 8 * hh + e) * 512];
  }
  const int c = h * 64 + lane;
  const float* cvp = p.in[I_CONV] + (size_t)l * 3 * 1536;
  const int jblk = w >> 1, iblk = w & 1;
  f32x16 Sacc;
#pragma unroll
  for (int i = 0; i < 16; ++i) Sacc[i] = 0.f;
  for (int i = tid; i < 64 * 72 / 2; i += 256) ((unsigned*)Sl)[i] = 0u;
  h16 xr[10], xk[10], xv[10];
  u32x4 af[4];
  auto prefetch = [&](int n0) {
    const bool lat = n0 >= 256;
    const int L = lat ? 4096 : 256;
    const int rowbase = lat ? b * 4096 : TL + b * 256;
    const int nn = (lat ? n0 - 256 : n0);
    const int P0 = d ? (L - 1 - (nn + 8 * w)) : (nn + 8 * w);
#pragma unroll
    for (int q = 0; q < 10; ++q) {
      const int pq = d ? (P0 + 1 - q) : (P0 - 1 + q);
      h16 a_ = (h16)0.f, b_ = (h16)0.f, c_ = (h16)0.f;
      if (pq >= 0 && pq < L) {
        const h16* x1 = rkv + (size_t)(rowbase + pq) * 1536 + c;
        a_ = x1[0]; b_ = x1[512]; c_ = x1[1024];
      }
      xr[q] = a_; xk[q] = b_; xv[q] = c_;
    }
  };
  auto prefetch_af = [&](int n0) {
    const bool lat = n0 >= 256;
    const int L = lat ? 4096 : 256;
    const int rowbase = lat ? b * 4096 : TL + b * 256;
    const int nn = (lat ? n0 - 256 : n0);
    const int nt = nn + r;
    const int pt = d ? (L - 1 - nt) : nt;
    const h16* lp = lora + (size_t)(rowbase + pt) * 384 + mat * 128 + d * 64 + 8 * hh;
#pragma unroll
    for (int ks = 0; ks < 4; ++ks) af[ks] = *(const u32x4*)(lp + ks * 16);
  };
  prefetch(0);
  prefetch_af(0);
  __syncthreads();
  const int lane_outer = lane;
  int* sflag = (int*)(smem + SMEM_BYTES - 12);
  int nsync = 0;
  const int ntarget = (int)gridDim.x - 128;
  for (int n0 = 0; n0 < 256 + 4096; n0 += 32) {
    const bool lat = n0 >= 256;
    const int L = lat ? 4096 : 256;
    const int rowbase = lat ? b * 4096 : TL + b * 256;
    const int nn = (lat ? n0 - 256 : n0);
    int lane = lane_outer;
    asm volatile("" : "+v"(lane));
    const int r = lane & 31, hh = lane >> 5;
    if (tid == 0) *sflag = (nsync < nhs) ? __hip_atomic_load(hint + nsync, __ATOMIC_RELAXED, __HIP_MEMORY_SCOPE_AGENT) : 0;
    {
      f32x16 acc;
#pragma unroll
      for (int i = 0; i < 16; ++i) acc[i] = 0.f;
#pragma unroll
      for (int ks = 0; ks < 4; ++ks) acc = MFMA(__builtin_bit_cast(h16x8, af[ks]), bf[ks], acc);
      float* rw = raw + mat * 2048 + nblk * 32 + r;
#pragma unroll
      for (int i = 0; i < 16; ++i) rw[(4 * hh + (i & 3) + 8 * (i >> 2)) * 64] = acc[i];
    }
    __syncthreads();
    const int arrived = *sflag;
    float lw[8], kkv[8], bbv[8], kmv[8], rrv[8], vvv[8], cl[8];
    float run = 0.f;
    const int cc = h * 64 + lane;
    const float w0 = p.in[I_W0][(l * 2 + d) * 512 + cc], a0 = p.in[I_A0][(l * 2 + d) * 512 + cc];
    const float kkc = p.in[I_KK][l * 512 + cc], kac = p.in[I_KA][l * 512 + cc], rkc = p.in[I_RK][l * 512 + cc];
    const float trA = cvp[(d ? 3072 : 0) + cc], tr1 = cvp[1536 + cc], trC = cvp[(d ? 0 : 3072) + cc];
    const float tkA = cvp[(d ? 3072 : 0) + 512 + cc], tk1 = cvp[1536 + 512 + cc], tkC = cvp[(d ? 0 : 3072) + 512 + cc];
    const float tvA = cvp[(d ? 3072 : 0) + 1024 + cc], tv1 = cvp[1536 + 1024 + cc], tvC = cvp[(d ? 0 : 3072) + 1024 + cc];
#pragma unroll
    for (int e = 0; e < 8; ++e) {
      const int tt = 8 * w + e;
      const int n = nn + tt;
      const int pos = d ? (L - 1 - n) : n;
      const size_t row = (size_t)rowbase + pos;
      const float rr = trA * (float)xr[e] + tr1 * (float)xr[e + 1] + trC * (float)xr[e + 2];
      const float kx = tkA * (float)xk[e] + tk1 * (float)xk[e + 1] + tkC * (float)xk[e + 2];
      const float vv = tvA * (float)xv[e] + tv1 * (float)xv[e + 1] + tvC * (float)xv[e + 2];
      const float wr = w0 + raw[tt * 64 + lane], ar = a0 + raw[2048 + tt * 64 + lane];
      const float z = -wr;
      const float sp = fmaxf(z, 0.f) + __logf(1.f + __expf(-fabsf(z)));
      const float lgw = -__expf(-sp - 0.5f);
      const float aa = sigmoidf_(ar);
      const float kkr = kx * kkc;
      const float kkn = kkr * __builtin_amdgcn_rsqf(fmaxf(wave_sum(kkr * kkr), 1e-24f));
      const float km = kx * (1.f + (aa - 1.f) * kac);
      const float bon = wave_sum(rr * km * rkc);
      if (lane == 0) bs[((size_t)d * TA + row) * 8 + h] = bon;
      run += lgw;
      lw[e] = lgw; cl[e] = run; kkv[e] = kkn; bbv[e] = kkn * aa; kmv[e] = km; rrv[e] = rr; vvv[e] = vv;
    }
    tot[w * 64 + lane] = run;
    __syncthreads();
    {
      const float t0 = tot[lane], t1 = tot[64 + lane], t2 = tot[128 + lane], t3 = tot[192 + lane];
      const float total = t0 + t1 + t2 + t3;
      const float prefix = (w > 0 ? t0 : 0.f) + (w > 1 ? t1 : 0.f) + (w > 2 ? t2 : 0.f);
      if (w == 0) GL[lane] = __expf(total);
      b16x8 bgv, kgv, vtv;
#pragma unroll
      for (int e = 0; e < 8; ++e) {
        const int tt = 8 * w + e;
        const float g = prefix + cl[e];
        const float eg = __expf(g), ege = __expf(g - lw[e]);
        const float eng = __builtin_amdgcn_rcpf(eg);
        const float egl = __expf(total - g);
        Qt[tt * 72 + lane] = (b16)(kkv[e] * ege);
        Rt[tt * 72 + lane] = (b16)(rrv[e] * eg);
        Bt[tt * 72 + lane] = (b16)(bbv[e] * eng);
        Kt[tt * 72 + lane] = (b16)(kmv[e] * eng);
        bgv[e] = (b16)(bbv[e] * egl);
        kgv[e] = (b16)(kmv[e] * egl);
        vtv[e] = (b16)vvv[e];
      }
      *(b16x8*)(BgT + lane * 40 + 8 * w) = bgv;
      *(b16x8*)(KgT + lane * 40 + 8 * w) = kgv;
      *(b16x8*)(VT + lane * 40 + 8 * w) = vtv;
    }
    __syncthreads();
    {
      const b16* X = (w < 2) ? Qt : Rt;
      const b16* Y = (w & 1) ? Kt : Bt;
      f32x16 acc;
#pragma unroll
      for (int i = 0; i < 16; ++i) acc[i] = 0.f;
#pragma unroll
      for (int ks = 0; ks < 4; ++ks) {
        b16x8 a = *(const b16x8*)(X + r * 72 + ks * 16 + 8 * hh);
        b16x8 bb = *(const b16x8*)(Y + r * 72 + ks * 16 + 8 * hh);
        acc = MFMAB(a, bb, acc);
      }
#pragma unroll
      for (int i = 0; i < 16; ++i) {
        const int t = 4 * hh + (i & 3) + 8 * (i >> 2);
        const bool keep = (w < 2) ? (r < t) : (r <= t);
        const float v = keep ? acc[i] : 0.f;
        if (w == 0) Am[t * 36 + r] = v;
        else if (w == 1) Bm[t * 40 + r] = (b16)v;
        else if (w == 2) A2[t * 40 + r] = (b16)v;
        else B2[t * 40 + r] = (b16)v;
      }
    }
    __syncthreads();
    if (w < 2) {
      f32x16 acc;
#pragma unroll
      for (int i = 0; i < 16; ++i) acc[i] = 0.f;
#pragma unroll
      for (int ks = 0; ks < 4; ++ks) {
        b16x8 a = *(const b16x8*)(Qt + r * 72 + ks * 16 + 8 * hh);
        b16x8 bb = *(const b16x8*)(Sl + (iblk * 32 + r) * 72 + ks * 16 + 8 * hh);
        acc = MFMAB(a, bb, acc);
      }
#pragma unroll
      for (int ks = 0; ks < 2; ++ks) {
        b16x8 a = *(const b16x8*)(Bm + r * 40 + ks * 16 + 8 * hh);
        b16x8 bb = *(const b16x8*)(VT + (iblk * 32 + r) * 40 + ks * 16 + 8 * hh);
        acc = MFMAB(a, bb, acc);
      }
#pragma unroll
      for (int i = 0; i < 16; ++i) GT[(4 * hh + (i & 3) + 8 * (i >> 2)) * 64 + iblk * 32 + r] = -acc[i];
    }
    __syncthreads();
    {
      if (n0 + 32 < 256 + 4096) prefetch_af(n0 + 32);
      const int q = lane & 3, col = 16 * w + (lane >> 2);
      float uq[8];
#pragma unroll
      for (int e = 0; e < 8; ++e) uq[e] = 0.f;
      int o0 = 0, o1 = 0;
#pragma unroll
      for (int t = 0; t < 32; ++t) {
        const int oo = (t & 1) ? o1 : o0;
        const float gt = GT[t * 64 + col + oo];
        float ut = gt;
        if (t > 0) {
          const f32x4 am0 = *(const f32x4*)(Am + t * 36 + 8 * q + oo);
          const f32x4 am1 = *(const f32x4*)(Am + t * 36 + 8 * q + 4 + oo);
          float part = (am0.x * uq[0] + am0.y * uq[1]) + (am0.z * uq[2] + am0.w * uq[3]);
          part += (am1.x * uq[4] + am1.y * uq[5]) + (am1.z * uq[6] + am1.w * uq[7]);
          ut = gt - quad_sum(part);
        }
        uq[t & 7] = (q == (t >> 3)) ? ut : uq[t & 7];
        if (t & 1) asm volatile("" : "+v"(o1) : "v"(ut)); else asm volatile("" : "+v"(o0) : "v"(ut));
      }
      b16x8 o;
#pragma unroll
      for (int e = 0; e < 8; ++e) o[e] = (b16)uq[e];
      *(b16x8*)(UTt + col * 40 + 8 * q) = o;
      if (n0 + 32 < 256 + 4096) prefetch(n0 + 32);
    }
    __syncthreads();
    if (w >= 2) {
      f32x16 Yacc;
#pragma unroll
      for (int i = 0; i < 16; ++i) Yacc[i] = 0.f;
#pragma unroll
      for (int ks = 0; ks < 4; ++ks) {
        b16x8 a = *(const b16x8*)(Rt + r * 72 + ks * 16 + 8 * hh);
        b16x8 bb = *(const b16x8*)(Sl + (iblk * 32 + r) * 72 + ks * 16 + 8 * hh);
        Yacc = MFMAB(a, bb, Yacc);
      }
#pragma unroll
      for (int ks = 0; ks < 2; ++ks) {
        b16x8 a = *(const b16x8*)(B2 + r * 40 + ks * 16 + 8 * hh);
        b16x8 bb = *(const b16x8*)(VT + (iblk * 32 + r) * 40 + ks * 16 + 8 * hh);
        Yacc = MFMAB(a, bb, Yacc);
      }
#pragma unroll
      for (int ks = 0; ks < 2; ++ks) {
        b16x8 a = *(const b16x8*)(A2 + r * 40 + ks * 16 + 8 * hh);
        b16x8 bb = *(const b16x8*)(UTt + (iblk * 32 + r) * 40 + ks * 16 + 8 * hh);
        Yacc = MFMAB(a, bb, Yacc);
      }
#pragma unroll
      for (int i = 0; i < 16; ++i) {
        const int t = 4 * hh + (i & 3) + 8 * (i >> 2);
        const int n = nn + t;
        const int pos = d ? (L - 1 - n) : n;
        so[((size_t)rowbase + pos) * 512 + h * 64 + iblk * 32 + r] = (h16)Yacc[i];
      }
    }
    __syncthreads();
    {
#pragma unroll
      for (int g4 = 0; g4 < 4; ++g4) {
        const f32x4 gl4 = *(const f32x4*)(GL + jblk * 32 + 8 * g4 + 4 * hh);
        Sacc[4 * g4 + 0] *= gl4.x; Sacc[4 * g4 + 1] *= gl4.y; Sacc[4 * g4 + 2] *= gl4.z; Sacc[4 * g4 + 3] *= gl4.w;
      }
#pragma unroll
      for (int ks = 0; ks < 2; ++ks) {
        b16x8 a = *(const b16x8*)(BgT + (jblk * 32 + r) * 40 + ks * 16 + 8 * hh);
        b16x8 bb = *(const b16x8*)(UTt + (iblk * 32 + r) * 40 + ks * 16 + 8 * hh);
        Sacc = MFMAB(a, bb, Sacc);
      }
#pragma unroll
      for (int ks = 0; ks < 2; ++ks) {
        b16x8 a = *(const b16x8*)(KgT + (jblk * 32 + r) * 40 + ks * 16 + 8 * hh);
        b16x8 bb = *(const b16x8*)(VT + (iblk * 32 + r) * 40 + ks * 16 + 8 * hh);
        Sacc = MFMAB(a, bb, Sacc);
      }
#pragma unroll
      for (int g4 = 0; g4 < 4; ++g4) {
        b16x4 o;
        o.x = (b16)Sacc[4 * g4 + 0]; o.y = (b16)Sacc[4 * g4 + 1]; o.z = (b16)Sacc[4 * g4 + 2]; o.w = (b16)Sacc[4 * g4 + 3];
        *(b16x4*)(Sl + (iblk * 32 + r) * 72 + jblk * 32 + 8 * g4 + 4 * hh) = o;
      }
    }
    __syncthreads();
    if (nsync < nhs && arrived >= ntarget) { xcd_barrier(*xb); ++nsync; }
  }
  while (nsync < nhs) { xcd_barrier(*xb); ++nsync; }
}

DI void phase_attn(const P& p, int l, int rep, char* smem) {
  const int xcd = BIDX() & 7, j = BIDX() >> 3;
  if (j < 16 && !(rep == 1 && DUPMODE == 2)) {
    __builtin_amdgcn_s_setprio(3);
    scan_chain_c(p, l, (j >> 3) * 64 + xcd * 8 + (j & 7), smem, nullptr, nullptr, 0);
    __builtin_amdgcn_s_setprio(0);
  }
  if (rep == 1 && DUPMODE == 1) return;
  int* ctr = (int*)(p.ws + OFF_CTR) + (rep * 2 + l) * 8 + xcd;
  const int nit = (l == 1) ? 512 : 544;
  int* sit = (int*)(smem + SMEM_BYTES - 16);
  for (;;) {
    __syncthreads();
    if (TIDX() == 0) *sit = atomicAdd(ctr, 1);
    __syncthreads();
    const int it = *sit;
    if (it >= nit) break;
    attn_dispatch(p, xcd, it, smem);
  }
}

DI void phase_mixer(const P& p, int l, const XcdBarrier& xb, char* smem) {
  const int xcd = BIDX() & 7, j = BIDX() >> 3;
  int* cbase = (int*)(p.ws + OFF_CTR);
  int* hint = cbase + 40 + l * 2;
  if (j < 16) {
    __builtin_amdgcn_s_setprio(3);
    scan_chain_c(p, l, (j >> 3) * 64 + xcd * 8 + (j & 7), smem, &xb, hint, 2);
    __builtin_amdgcn_s_setprio(0);
  } else {
    const int geff = (int)gridDim.x - 128;
    phase_prep(p, l, 128, geff);
    __syncthreads();
    if (TIDX() == 0) atomicAdd(hint, 1);
    xcd_barrier(xb);
    phase_uproj(p, l, smem, 128, geff);
    __syncthreads();
    if (TIDX() == 0) atomicAdd(hint + 1, 1);
    xcd_barrier(xb);
  }
  int* ctr = cbase + l * 8 + xcd;
  const int nit = (l == 1) ? 512 : 544;
  int* sit = (int*)(smem + SMEM_BYTES - 16);
  for (;;) {
    __syncthreads();
    if (TIDX() == 0) *sit = atomicAdd(ctr, 1);
    __syncthreads();
    const int it = *sit;
    if (it >= nit) break;
    attn_dispatch(p, xcd, it, smem);
  }
}

DI void phase_post(const P& p, int l, char* smem) {
  const h16* W = (const h16*)(p.ws + OFF_W16) + WO_G2;
  h16* rkv = (h16*)(p.ws + OFF_R1);
  const h16* lora = rkv + (size_t)TA * 1536;
  const h16* sof = (const h16*)(p.ws + OFF_HB);
  const h16* sob = sof + (size_t)TA * 512;
  const float* bs = (const float*)(p.ws + OFF_BS);
  const float* lng = p.in[I_LNG] + l * 512;
  const float* lnb = p.in[I_LNB] + l * 512;
  const float* cvp = p.in[I_CONV] + (size_t)l * 3 * 1536 + 1024;
  const int ntok = (l == 1) ? 256 : 272;
  const int nt = 4 * ntok;
  const int lane = TIDX() & 63, w = TIDX() >> 6, wm = w >> 1, wn = w & 1, hh = lane >> 5;
  for (int t = BIDX(); t < nt; t += gridDim.x) {
    const int m0 = (t & 3) * 128, n0 = (t >> 2) * 128;
    f32x16 acc[2][2];
    zero_acc(acc);
    gemm_tile(W + (size_t)m0 * 128, 128, lora + (size_t)n0 * 384 + 256, 384, 128, acc, (h16*)smem);
    const int head = (m0 + wm * 64) >> 6;
#pragma unroll
    for (int ni = 0; ni < 2; ++ni) {
      const int row = n0 + wn * 64 + ni * 32 + (lane & 31);
      const bool lat = row < TL;
      const int pos = lat ? (row & 4095) : ((row - TL) & 255);
      const int L = lat ? 4096 : 256;
      float y[2][16];
      float sum = 0.f;
#pragma unroll
      for (int mi = 0; mi < 2; ++mi)
#pragma unroll
        for (int g = 0; g < 4; ++g) {
          const int cb_ = m0 + wm * 64 + mi * 32 + 8 * g + 4 * hh;
          h16x4 f = *(const h16x4*)(sof + (size_t)row * 512 + cb_), bk = *(const h16x4*)(sob + (size_t)row * 512 + cb_);
          y[mi][4 * g + 0] = (float)f.x + (float)bk.x; y[mi][4 * g + 1] = (float)f.y + (float)bk.y;
          y[mi][4 * g + 2] = (float)f.z + (float)bk.z; y[mi][4 * g + 3] = (float)f.w + (float)bk.w;
          sum += y[mi][4 * g] + y[mi][4 * g + 1] + y[mi][4 * g + 2] + y[mi][4 * g + 3];
        }
      sum += shx(sum, 32);
      const float mean = sum * (1.f / 64.f);
      float vs = 0.f;
#pragma unroll
      for (int mi = 0; mi < 2; ++mi)
#pragma unroll
        for (int i = 0; i < 16; ++i) { const float dlt = y[mi][i] - mean; vs += dlt * dlt; }
      vs += shx(vs, 32);
      const float rstd = rsqrtf(vs * (1.f / 64.f) + 64e-5f);
      const float bsum = bs[(size_t)row * 8 + head] + bs[((size_t)TA + row) * 8 + head];
#pragma unroll
      for (int mi = 0; mi < 2; ++mi)
#pragma unroll
        for (int g = 0; g < 4; ++g) {
          const int cb_ = m0 + wm * 64 + mi * 32 + 8 * g + 4 * hh;
          const h16* vp = rkv + (size_t)row * 1536 + 1024 + cb_;
          h16x4 v1 = *(const h16x4*)vp, v0, v2;
          v0.x = v0.y = v0.z = v0.w = (h16)0.f; v2 = v0;
          if (pos > 0) v0 = *(const h16x4*)(vp - 1536);
          if (pos < L - 1) v2 = *(const h16x4*)(vp + 1536);
          h16x4 o;
#pragma unroll
          for (int e = 0; e < 4; ++e) {
            const int cc = cb_ + e;
            const float vv = cvp[cc] * (float)v0[e] + cvp[1536 + cc] * (float)v1[e] + cvp[3072 + cc] * (float)v2[e];
            const float val = ((y[mi][4 * g + e] - mean) * rstd * lng[cc] + lnb[cc] + bsum * vv) * acc[mi][ni][4 * g + e];
            o[e] = (h16)val;
          }
          *(h16x4*)(rkv + (size_t)row * 1536 + cb_) = o;
        }
      __builtin_amdgcn_sched_barrier(0);
    }
  }
  const float* xl = l == 0 ? p.in[I_X] : p.out;
  const float* xc = l == 0 ? p.in[I_CTX] : (const float*)(p.ws + OFF_XC);
  rows_norm_mod(p, xl, xc, l, p.in[I_APRE] + l * 1024, 0, 1, (h16*)(p.ws + OFF_HRE), (l == 1) ? TL : TA);
}

DI void phase_merge(const P& p, int l, char* smem) {
  const h16* W = (const h16*)(p.ws + OFF_W16);
  const h16* hre = (const h16*)(p.ws + OFF_HRE);
  const h16* oa = (const h16*)(p.ws + OFF_X);
  const h16* ob = oa + (size_t)TA * 512;
  const h16* oc = (const h16*)(p.ws + OFF_R1);
  h16* accb = (h16*)(p.ws + OFF_ACC);
  const int Mx = (l == 1) ? 32 : 34;
  XCD_LOOP(Mx, 8) {
    int mt_, nt_;
    tile_map(u_, Mx, 8, xcd_, mt_, nt_);
    const int m0 = mt_ * 128, n0 = nt_ * 128;
    h16x2 accp[2][2][8];
#pragma unroll
    for (int a = 0; a < 2; ++a)
#pragma unroll
      for (int bq = 0; bq < 2; ++bq)
#pragma unroll
        for (int i = 0; i < 8; ++i) { accp[a][bq][i].x = (h16)0.f; accp[a][bq][i].y = (h16)0.f; }
    u32x4 cra[4], crb[4];
#pragma unroll 1
    for (int n = 0; n < 3; ++n) {
      h16x2 gp[2][2][8];
      const h16* br = n == 0 ? oa + (size_t)m0 * 512 : (n == 1 ? ob + (size_t)m0 * 512 : oc + (size_t)m0 * 1536);
      const int ldbr = n == 2 ? 1536 : 512;
      const h16* wbr = W + WO_WB + ((size_t)n * 1024 + n0) * 512;
      {
        f32x16 ag[2][2];
        zero_acc(ag);
        gemm_tile_c(hre + (size_t)m0 * 1024, 1024, W + WO_WIN + (size_t)(3360 + n * 1024 + n0) * 1024, 1024, 1024, ag, (h16*)smem,
                    cra, crb, n > 0, br, ldbr, wbr, 512);
#pragma unroll
        for (int a = 0; a < 2; ++a)
#pragma unroll
          for (int bq = 0; bq < 2; ++bq)
#pragma unroll
            for (int i = 0; i < 8; ++i) {
              h16x2 t; t.x = (h16)sigmoidf_(ag[a][bq][2 * i]); t.y = (h16)sigmoidf_(ag[a][bq][2 * i + 1]);
              gp[a][bq][i] = t;
            }
      }
      f32x16 ab[2][2];
      zero_acc(ab);
      gemm_tile_c(br, ldbr, wbr, 512, 512, ab, (h16*)smem, cra, crb, true,
                  n < 2 ? hre + (size_t)m0 * 1024 : nullptr, 1024, W + WO_WIN + (size_t)(3360 + (n + 1) * 1024 + n0) * 1024, 1024);
#pragma unroll
      for (int a = 0; a < 2; ++a)
#pragma unroll
        for (int bq = 0; bq < 2; ++bq)
#pragma unroll
          for (int i = 0; i < 8; ++i) {
            h16x2 t;
            t.x = (h16)((float)accp[a][bq][i].x + (float)gp[a][bq][i].x * ab[a][bq][2 * i]);
            t.y = (h16)((float)accp[a][bq][i].y + (float)gp[a][bq][i].y * ab[a][bq][2 * i + 1]);
            accp[a][bq][i] = t;
          }
    }
    {
      const int lane = TIDX() & 63, w = TIDX() >> 6, wm = w >> 1, wn = w & 1, hh = lane >> 5, c = lane & 31;
#pragma unroll
      for (int mi = 0; mi < 2; ++mi)
#pragma unroll
        for (int ni = 0; ni < 2; ++ni) {
          const int rbase = m0 + wm * 64 + mi * 32 + 4 * hh, n = n0 + wn * 64 + ni * 32 + c;
#pragma unroll
          for (int i = 0; i < 8; ++i) {
            accb[(size_t)EROW(rbase, 2 * i) * 1024 + n] = accp[mi][ni][i].x;
            accb[(size_t)EROW(rbase, 2 * i + 1) * 1024 + n] = accp[mi][ni][i].y;
          }
        }
    }
  }
}

DI void phase_gemm_plain(const h16* A, int lda, const h16* Bt, int K, h16* C, int ldc, int mt0, int mt1, int ntn, char* smem) {
  const int Mx = (mt1 - mt0) >> 3;
  XCD_LOOP(Mx, ntn) {
    int mt_, nt_;
    tile_map(u_, Mx, ntn, xcd_, mt_, nt_);
    const int m0 = (mt0 + mt_) * 128, n0 = nt_ * 128;
    f32x16 acc[2][2];
    zero_acc(acc);
    gemm_tile_deep(A + (size_t)m0 * lda, lda, Bt + (size_t)n0 * K, K, K, acc, (h16*)smem);
    epi_foreach(acc, m0, n0, [&](int rbase, int n, const f32x16& v) {
#pragma unroll
      for (int i = 0; i < 16; ++i) C[(size_t)EROW(rbase, i) * ldc + n] = (h16)v[i];
    });
  }
}

DI void phase_ffn1(const P& p, int l, int hf, char* smem) {
  const h16* W = (const h16*)(p.ws + OFF_W16) + WO_FIN;
  const h16* h2 = (const h16*)(p.ws + OFF_X);
  h16* act = (h16*)(p.ws + OFF_HB);
  const int mt0 = 0;
  const int mt1 = (l == 1) ? 256 : 272;
  const int Mt = (mt1 - mt0) >> 1;
  XCD_LOOP_W(Mt, 44) {
    int mt_, nt_;
    tile_map(u_, Mx_, 44, xcd_, mt_, nt_);
    if (mt_ >= Mt) continue;
    const int m0 = mt0 * 128 + mt_ * 256, c0 = nt_ * 64;
    f32x16 acc[4][2];
    zero_acc_w(acc);
    gemm_tile_w(h2 + (size_t)m0 * 1024, 1024, W, 1024,
                [&](int rr) { const int q = rr & 63; return ((q >> 5) ? 2816 : 0) + c0 + (rr >> 6) * 32 + (q & 31); }, 1024, acc, (h16*)smem);
    const int lane = TIDX() & 63, w = TIDX() >> 6, wm = w >> 1, wn = w & 1, hh = lane >> 5, c = lane & 31;
    const int ml0 = m0 - mt0 * 128;
#pragma unroll
    for (int mi = 0; mi < 4; ++mi) {
      const int rbase = ml0 + wm * 128 + mi * 32 + 4 * hh, n = c0 + wn * 32 + c;
#pragma unroll
      for (int i = 0; i < 16; ++i) {
        const float g = acc[mi][0][i];
        act[(size_t)EROW(rbase, i) * 2816 + n] = (h16)(g * sigmoidf_(g) * acc[mi][1][i]);
      }
    }
  }
}
DI void phase_ffn2(const P& p, int l, int hf, char* smem) {
  const h16* W = (const h16*)(p.ws + OFF_W16) + WO_FOUT;
  const h16* act = (const h16*)(p.ws + OFF_HB);
  h16* f = (h16*)(p.ws + OFF_QM);
  phase_gemm_plain(act, 2816, W, 2816, f, 1024, 0, (l == 1) ? 256 : 272, 8, smem);
}

#if BENCH
DI void phase_bench(const P& p, char* smem) {
  const int lane = TIDX() & 63;
  f32x16 c0, c1, c2, c3;
#pragma unroll
  for (int i = 0; i < 16; ++i) { c0[i] = 0.f; c1[i] = 0.f; c2[i] = 0.f; c3[i] = 0.f; }
  h16x8 a, b;
#pragma unroll
  for (int i = 0; i < 8; ++i) { a[i] = (h16)(0.001f * (lane + i)); b[i] = (h16)(0.002f * (lane - i)); }
#pragma unroll 1
  for (int it = 0; it < 4096; ++it) {
    c0 = MFMA(a, b, c0); c1 = MFMA(a, b, c1); c2 = MFMA(a, b, c2); c3 = MFMA(a, b, c3);
  }
  float r = c0[0] + c1[1] + c2[2] + c3[3];
  if (r == 123.456f) ((float*)(p.ws + OFF_CTR))[60] = r;
}
#endif
enum { PH_INIT = 0, PH_NORM0, PH_PROJ, PH_PREP, PH_UPROJ, PH_ATTN, PH_SCAN, PH_POST, PH_MERGE, PH_WOUT, PH_RES1, PH_FFN1, PH_FFN2, PH_RES2 };

DI void run_phase(const P& p, int ph, int l, int hf, char* smem) {
  const int nrows = (l == 1) ? TL : TA;
  const float* xl = l == 0 ? p.in[I_X] : p.out;
  const float* xc = l == 0 ? p.in[I_CTX] : (const float*)(p.ws + OFF_XC);
  switch (ph) {
    case PH_INIT: phase_init(p, smem); break;
    case PH_NORM0: rows_norm_mod(p, p.in[I_X], p.in[I_CTX], 0, p.in[I_APRE], 0, 1, (h16*)(p.ws + OFF_HB), TA); break;
    case PH_PROJ: phase_proj(p, l, smem); break;
    case PH_PREP: phase_prep(p, l, 0, (int)gridDim.x); break;
    case PH_UPROJ: phase_uproj(p, l, smem, 0, (int)gridDim.x); break;
    case PH_ATTN: phase_attn(p, l, hf, smem); break;
    case PH_POST: phase_post(p, l, smem); break;
    case PH_MERGE: phase_merge(p, l, smem); break;
    case PH_WOUT:
      phase_gemm_plain((const h16*)(p.ws + OFF_ACC), 1024, (const h16*)(p.ws + OFF_W16) + WO_WOUT, 1024, (h16*)(p.ws + OFF_HB), 1024, 0,
                       (l == 1) ? 256 : 272, 8, smem);
      break;
    case PH_RES1:
      rows_resid_norm(p, xl, xc, (const h16*)(p.ws + OFF_HB), l, 2, p.in[I_APOST] + l * 1024, true, l, p.in[I_FPRE] + l * 1024, 3, 4,
                      (h16*)(p.ws + OFF_X), nrows);
      break;
    case PH_FFN1: phase_ffn1(p, l, hf, smem); break;
    case PH_FFN2: phase_ffn2(p, l, hf, smem); break;
    case PH_RES2:
      rows_resid_norm(p, p.out, (const float*)(p.ws + OFF_XC), (const h16*)(p.ws + OFF_QM), l, 5, p.in[I_FPOST] + l * 1024, l == 0, 1,
                      p.in[I_APRE] + 1024, 0, 1, (h16*)(p.ws + OFF_HB), nrows);
      if (l == 0) conv_weights(p, 1, smem);
      break;
  }
}

template <int PH>
__global__ void __launch_bounds__(256) k_phase(P p, int l, int hf) {
  __shared__ __attribute__((aligned(16))) char smem[SMEM_BYTES];
  run_phase(p, PH, l, hf, smem);
}

#if MEGA
__global__ void __launch_bounds__(256, 2) k_mega(P p) {
  __shared__ __attribute__((aligned(16))) char smem[SMEM_BYTES];
  cg::grid_group grid = cg::this_grid();
  __shared__ __attribute__((aligned(16))) unsigned xb_words[4];
  if (threadIdx.x < 4) xb_words[threadIdx.x] = 0u;
  __syncthreads();
  const XcdBarrier xb = xcd_barrier_post((unsigned*)(p.ws + OFF_BAR), (volatile LAS unsigned*)xb_words);
#pragma unroll 1
  for (int step = 0; step < 20; ++step) {
    int ph, l = 0, hf = 0;
    if (step < 2) ph = step;
    else {
      const int s = step - 2;
      l = s / 9;
      const int k = s - l * 9;
      ph = (k == 0) ? PH_PROJ : (k == 1 ? 14 : k + 5);
    }
    P q = p;
    size_t z0 = 0;
    asm volatile("" : "+s"(z0));
    q.ws = p.ws + z0;
    q.out = p.out + z0;
    if (ph == 14) phase_mixer(q, l, xb, smem);
    else run_phase(q, ph, l, hf, smem);
#if BENCH
    if (step == 0) { grid.sync(); phase_bench(q, smem); }
#endif
#if DUPMASK
    if ((DUPMASK >> ph) & 1) {
      grid.sync();
      run_phase(q, ph, l, ph == PH_ATTN ? 1 : hf, smem);
    }
#endif
    if (step < 19) xcd_barrier(xb);
    if (gridDim.y == 7777u) grid.sync();
  }
}
#endif

extern "C" void kernel_launch(void* const* d_in, const int* in_sizes, int n_in, void* d_out, int out_size, void* d_ws, size_t ws_size,
                              hipStream_t stream) {
  P p{};
  for (int i = 0; i < N_IN; ++i) p.in[i] = (const float*)d_in[i];
  p.out = (float*)d_out;
  p.ws = (char*)d_ws;
  if (ws_size < OFF_END) { fprintf(stderr, "workspace too small: %zu < %zu\n", ws_size, (size_t)OFF_END); return; }
#if MEGA
  static int grid_blocks = 0;
  if (!grid_blocks) {
    int dev = 0, cus = 0, per_cu = 0;
    hipGetDevice(&dev);
    hipDeviceGetAttribute(&cus, hipDeviceAttributeMultiprocessorCount, dev);
    hipOccupancyMaxActiveBlocksPerMultiprocessor(&per_cu, k_mega, 256, 0);
    if (per_cu > 2) per_cu = 2;
    grid_blocks = cus * per_cu;
  }
  hipMemsetAsync((char*)d_ws + OFF_BAR, 0, 3456 * 4, stream);
  void* args[] = {&p};
  hipError_t e = hipLaunchCooperativeKernel((void*)k_mega, dim3(grid_blocks), dim3(256), args, 0, stream);
  if (e != hipSuccess) fprintf(stderr, "cooperative launch failed: %s (grid %d)\n", hipGetErrorString(e), grid_blocks);
#else
  const int G = 512;
#define L(ph, l, hf) hipLaunchKernelGGL(k_phase<ph>, dim3(G), dim3(256), 0, stream, p, l, hf)
  L(PH_INIT, 0, 0);
  L(PH_NORM0, 0, 0);
  for (int l = 0; l < 2; ++l) {
    L(PH_PROJ, l, 0); L(PH_PREP, l, 0); L(PH_UPROJ, l, 0); L(PH_ATTN, l, 0); L(PH_POST, l, 0); L(PH_MERGE, l, 0);
    L(PH_WOUT, l, 0); L(PH_RES1, l, 0); L(PH_FFN1, l, 0); L(PH_FFN2, l, 0); L(PH_RES2, l, 0);
  }
#undef L
#endif
}
```

```cpp
#include <hip/hip_runtime.h>
#include <hip/hip_cooperative_groups.h>
#include <cstdio>
namespace cg = cooperative_groups;

#ifndef MEGA
#define MEGA 1
#endif
#ifndef DUPMASK
#define DUPMASK 0
#endif
#ifndef DUPMODE
#define DUPMODE 0
#endif
#ifndef BENCH
#define BENCH 0
#endif

typedef _Float16 h16;
typedef h16 h16x8 __attribute__((ext_vector_type(8)));
typedef h16 h16x4 __attribute__((ext_vector_type(4)));
typedef h16 h16x2 __attribute__((ext_vector_type(2)));
typedef float f32x16 __attribute__((ext_vector_type(16)));
typedef float f32x4 __attribute__((ext_vector_type(4)));
typedef float f32x2 __attribute__((ext_vector_type(2)));
typedef unsigned u32x4 __attribute__((ext_vector_type(4)));
typedef __bf16 b16;
typedef b16 b16x8 __attribute__((ext_vector_type(8)));
typedef b16 b16x4 __attribute__((ext_vector_type(4)));
#define MFMAB(a, b, c) __builtin_amdgcn_mfma_f32_32x32x16_bf16((a), (b), (c), 0, 0, 0)

#define DI __device__ __forceinline__
#define MFMA(a, b, c) __builtin_amdgcn_mfma_f32_32x32x16_f16((a), (b), (c), 0, 0, 0)

enum { I_X = 0, I_C, I_CTX, I_CCTX, I_ADAW, I_ADAB, I_APRE, I_APOST, I_FPRE, I_FPOST, I_WIN, I_QNORM, I_KVNORM, I_WUQ, I_WUKV,
       I_GQN, I_GKN, I_CONV, I_W0, I_W2, I_A0, I_A2, I_G2, I_KK, I_KA, I_RK, I_LNG, I_LNB, I_WB, I_WOUT, I_FIN, I_FOUT, N_IN };

struct P { const float* in[N_IN]; float* out; char* ws; };

constexpr int TL = 32768, TA = 34816, SA = 4352;
constexpr float EPS = 1e-6f;
constexpr float LOG2E = 1.4426950408889634f;

constexpr size_t WO_WIN = 0, WO_UQ = WO_WIN + (size_t)6432 * 1024, WO_UKV = WO_UQ + 768 * 384, WO_G2 = WO_UKV + 1024 * 256,
                 WO_WB = WO_G2 + 512 * 128, WO_WOUT = WO_WB + (size_t)3 * 1024 * 512, WO_FIN = WO_WOUT + 1024 * 1024,
                 WO_FOUT = WO_FIN + (size_t)5632 * 1024, WO_END = WO_FOUT + (size_t)1024 * 2816;
constexpr size_t OFF_W16 = 0;
constexpr size_t OFF_MOD = OFF_W16 + WO_END * 2;
constexpr size_t OFF_ROPEM = OFF_MOD + (size_t)2 * 9 * 6144 * 4;
constexpr size_t OFF_ROPEG = OFF_ROPEM + (size_t)4096 * 16 * 8;
constexpr size_t OFF_XC = OFF_ROPEG + (size_t)4096 * 32 * 8;
constexpr size_t OFF_BS = OFF_XC + (size_t)2048 * 1024 * 4;
constexpr size_t OFF_KROT = OFF_BS + (size_t)2 * TA * 8 * 4;
constexpr size_t OFF_HB = OFF_KROT + (size_t)TA * 32 * 2;
constexpr size_t OFF_R1 = OFF_HB + (size_t)TA * 1024 * 2;
constexpr size_t OFF_X = OFF_R1 + (size_t)TA * 1920 * 2;
constexpr size_t OFF_QM = OFF_X + (size_t)TA * 1024 * 2;
constexpr size_t OFF_KN = OFF_QM + (size_t)TA * 768 * 2;
constexpr size_t OFF_VMT = OFF_KN + (size_t)TA * 512 * 2;
constexpr size_t OFF_QG = OFF_VMT + (size_t)TA * 512 * 2;
constexpr size_t OFF_KG = OFF_QG + (size_t)TA * 512 * 2;
constexpr size_t OFF_VGT = OFF_KG + (size_t)TA * 128 * 2;
constexpr size_t OFF_CTR = OFF_VGT + (size_t)TA * 128 * 2;
constexpr size_t OFF_BAR = OFF_CTR + 256;
constexpr size_t OFF_END = OFF_BAR + 3456 * 4;
constexpr size_t OFF_ACC = OFF_QM;
constexpr size_t OFF_HRE = OFF_QM + (size_t)TA * 1024 * 2;

constexpr int SMEM_BYTES = 73728;

DI int TIDX() { int t = threadIdx.x; asm volatile("" : "+v"(t)); return t; }
DI int BIDX() { int b = blockIdx.x; asm volatile("" : "+s"(b)); return b; }
DI float shx(float v, int mask) {
  const int lane = TIDX() & 63;
  return __int_as_float(__builtin_amdgcn_ds_bpermute((lane ^ mask) << 2, __float_as_int(v)));
}
#define XB_TMO      128
#define XB_XCNT(j)  (256  + 64 * (j))
#define XB_XSUB(j)  (1280 + 64 * (j))
#define XB_XGEN(j)  (2304 + 64 * (j))
#define XB_TOP      3328
#define XB_TOPGEN   3392
#define XB_SPIN_CAP (1u << 20)
#define LAS __attribute__((address_space(3)))
DI unsigned xb_ld(unsigned* p) { return __hip_atomic_load(p, __ATOMIC_RELAXED, __HIP_MEMORY_SCOPE_AGENT); }
DI unsigned xb_add(unsigned* p, unsigned v) { return __hip_atomic_fetch_add(p, v, __ATOMIC_RELAXED, __HIP_MEMORY_SCOPE_AGENT); }
DI unsigned xb_xcc_id() { return (unsigned)__builtin_amdgcn_s_getreg((3 << 11) | 20) & 0xFu; }
#define XB_SPIN(cond, bar) do { unsigned _sp = 0; while (cond) { __builtin_amdgcn_s_sleep(1); \
    if ((++_sp & 255u) == 0u) { if (xb_ld(&(bar)[XB_TMO])) break; if (_sp > XB_SPIN_CAP) { atomicAdd(&(bar)[XB_TMO], 1u); break; } } } } while (0)
struct XcdBarrier { unsigned* bar; unsigned x; volatile LAS unsigned* st; };
DI XcdBarrier xcd_barrier_post(unsigned* bar, volatile LAS unsigned* st) {
  XcdBarrier b; b.bar = bar; b.x = xb_xcc_id(); b.st = st;
  if (threadIdx.x == 0) (void)xb_add(&bar[XB_XCNT(b.x)], 1u);
  return b;
}
DI void xcd_barrier_complete(unsigned* bar, unsigned x, unsigned& nloc, unsigned& nx) {
  const unsigned G = gridDim.x * gridDim.y * gridDim.z;
  unsigned sum, cnt, mine, sp = 0u;
  for (;;) {
    sum = 0u; cnt = 0u; mine = 0u;
#pragma unroll
    for (unsigned j = 0; j < 16; ++j) { const unsigned c = xb_ld(&bar[XB_XCNT(j)]); sum += c; cnt += (c > 0u) ? 1u : 0u; mine = (j == x) ? c : mine; }
    if (sum == G) break;
    __builtin_amdgcn_s_sleep(1);
    if ((++sp & 255u) == 0u) { if (xb_ld(&bar[XB_TMO])) break; if (sp > XB_SPIN_CAP) { atomicAdd(&bar[XB_TMO], 1u); break; } }
  }
  nloc = mine > 0u ? mine : 1u; nx = cnt > 0u ? cnt : 1u;
}
DI void xcd_barrier(const XcdBarrier& b) {
  asm volatile("s_waitcnt vmcnt(0)" ::: "memory");
  __syncthreads();
  if (threadIdx.x == 0) {
    unsigned* bar = b.bar;
    __builtin_amdgcn_s_waitcnt(0);
    unsigned nloc = b.st[0], nx = b.st[1];
    if (nloc == 0u) { xcd_barrier_complete(bar, b.x, nloc, nx); b.st[0] = nloc; b.st[1] = nx; }
    const unsigned old = xb_add(&bar[XB_XSUB(b.x)], 1u);
    const unsigned gen = old / nloc;
    if (old + 1u == (gen + 1u) * nloc) {
      __builtin_amdgcn_fence(__ATOMIC_RELEASE, "agent");
      asm volatile("s_waitcnt vmcnt(0)" ::: "memory");
      const unsigned og = xb_add(&bar[XB_TOP], 1u);
      const unsigned tg = og / nx;
      if (og + 1u == (tg + 1u) * nx) xb_add(&bar[XB_TOPGEN], 1u);
      else XB_SPIN(xb_ld(&bar[XB_TOPGEN]) == tg, bar);
      __builtin_amdgcn_fence(__ATOMIC_ACQUIRE, "agent");
      xb_add(&bar[XB_XGEN(b.x)], 1u);
      asm volatile("s_waitcnt vmcnt(0)" ::: "memory");
    } else {
      XB_SPIN(xb_ld(&bar[XB_XGEN(b.x)]) == gen, bar);
      __builtin_amdgcn_fence(__ATOMIC_ACQUIRE, "agent");
      asm volatile("s_waitcnt vmcnt(0)" ::: "memory");
    }
  }
  __syncthreads();
}

DI float x32_sum(float v) {
  auto r = __builtin_amdgcn_permlane32_swap(__float_as_uint(v), __float_as_uint(v), false, false);
  return __uint_as_float(r[0]) + __uint_as_float(r[1]);
}
DI float x32_max(float v) {
  auto r = __builtin_amdgcn_permlane32_swap(__float_as_uint(v), __float_as_uint(v), false, false);
  return fmaxf(__uint_as_float(r[0]), __uint_as_float(r[1]));
}
DI float wave_sum(float v) {
  v += __int_as_float(__builtin_amdgcn_mov_dpp(__float_as_int(v), 0xB1, 0xF, 0xF, true));
  v += __int_as_float(__builtin_amdgcn_mov_dpp(__float_as_int(v), 0x4E, 0xF, 0xF, true));
  v += __int_as_float(__builtin_amdgcn_mov_dpp(__float_as_int(v), 0x141, 0xF, 0xF, true));
  v += __int_as_float(__builtin_amdgcn_mov_dpp(__float_as_int(v), 0x140, 0xF, 0xF, true));
  v += __int_as_float(__builtin_amdgcn_ds_swizzle(__float_as_int(v), 0x401F));
  return x32_sum(v);
}
DI float quad_sum(float v) {
  v += __int_as_float(__builtin_amdgcn_mov_dpp(__float_as_int(v), 0xB1, 0xF, 0xF, true));
  v += __int_as_float(__builtin_amdgcn_mov_dpp(__float_as_int(v), 0x4E, 0xF, 0xF, true));
  return v;
}
DI float sigmoidf_(float x) { return __builtin_amdgcn_rcpf(1.f + __expf(-x)); }
DI int srow_of(int row) {
  if (row < TL) return (row >> 12) * SA + (row & 4095);
  int rc = row - TL;
  return (rc >> 8) * SA + 4096 + (rc & 255);
}

constexpr int LSTR = 72;
DI void gemm_tile(const h16* __restrict__ A, int lda, const h16* __restrict__ B, int ldb, int K, f32x16 (&acc)[2][2], h16* sm) {
  const int tid = TIDX(), lane = tid & 63, w = tid >> 6, wm = w >> 1, wn = w & 1, r = lane & 31, hh = lane >> 5;
  const unsigned ao = (unsigned)(tid >> 3) * (unsigned)lda + (unsigned)(tid & 7) * 8u;
  const unsigned bo = (unsigned)(tid >> 3) * (unsigned)ldb + (unsigned)(tid & 7) * 8u;
  const h16* ag = A;
  const h16* bg = B;
  u32x4 ra[4], rb[4];
#pragma unroll
  for (int i = 0; i < 4; ++i) {
    ra[i] = *(const u32x4*)(ag + (ao + (unsigned)i * 32u * (unsigned)lda));
    rb[i] = *(const u32x4*)(bg + (bo + (unsigned)i * 32u * (unsigned)ldb));
  }
  const int nk = K >> 6;
  const int wofs = (tid >> 3) * LSTR + (tid & 7) * 8;
  for (int kt = 0; kt < nk; ++kt) {
    h16* sa = sm + (kt & 1) * (2 * 128 * LSTR);
    h16* sb = sa + 128 * LSTR;
#pragma unroll
    for (int i = 0; i < 4; ++i) {
      *(u32x4*)(sa + wofs + i * 32 * LSTR) = ra[i];
      *(u32x4*)(sb + wofs + i * 32 * LSTR) = rb[i];
    }
    __syncthreads();
    const h16* pa = sa + (wm * 64 + r) * LSTR + hh * 8;
    const h16* pb = sb + (wn * 64 + r) * LSTR + hh * 8;
    h16x8 fa[2][2], fb[2][2];
    fa[0][0] = *(const h16x8*)(pa); fa[0][1] = *(const h16x8*)(pa + 32 * LSTR);
    fb[0][0] = *(const h16x8*)(pb); fb[0][1] = *(const h16x8*)(pb + 32 * LSTR);
    __builtin_amdgcn_sched_barrier(0);
    if (kt + 1 < nk) {
      ag += 64; bg += 64;
#pragma unroll
      for (int i = 0; i < 4; ++i) {
        ra[i] = *(const u32x4*)(ag + (ao + (unsigned)i * 32u * (unsigned)lda));
        rb[i] = *(const u32x4*)(bg + (bo + (unsigned)i * 32u * (unsigned)ldb));
      }
    }
    __builtin_amdgcn_sched_barrier(0);
#pragma unroll
    for (int ks = 0; ks < 4; ++ks) {
      const int cur = ks & 1, nxt = cur ^ 1;
      if (ks < 3) {
        fa[nxt][0] = *(const h16x8*)(pa + (ks + 1) * 16); fa[nxt][1] = *(const h16x8*)(pa + 32 * LSTR + (ks + 1) * 16);
        fb[nxt][0] = *(const h16x8*)(pb + (ks + 1) * 16); fb[nxt][1] = *(const h16x8*)(pb + 32 * LSTR + (ks + 1) * 16);
      }
      acc[0][0] = MFMA(fa[cur][0], fb[cur][0], acc[0][0]);
      acc[0][1] = MFMA(fa[cur][0], fb[cur][1], acc[0][1]);
      acc[1][0] = MFMA(fa[cur][1], fb[cur][0], acc[1][0]);
      acc[1][1] = MFMA(fa[cur][1], fb[cur][1], acc[1][1]);
      __builtin_amdgcn_sched_barrier(0);
    }
  }
  __syncthreads();
}
DI void gemm_tile_deep(const h16* __restrict__ A, int lda, const h16* __restrict__ B, int ldb, int K, f32x16 (&acc)[2][2], h16* sm) {
  const int tid = TIDX(), lane = tid & 63, w = tid >> 6, wm = w >> 1, wn = w & 1, r = lane & 31, hh = lane >> 5;
  const unsigned ao = (unsigned)(tid >> 3) * (unsigned)lda + (unsigned)(tid & 7) * 8u;
  const unsigned bo = (unsigned)(tid >> 3) * (unsigned)ldb + (unsigned)(tid & 7) * 8u;
  const h16* ag = A;
  const h16* bg = B;
  u32x4 ra0[4], rb0[4], ra1[4], rb1[4];
#pragma unroll
  for (int i = 0; i < 4; ++i) {
    ra0[i] = *(const u32x4*)(ag + (ao + (unsigned)i * 32u * (unsigned)lda));
    rb0[i] = *(const u32x4*)(bg + (bo + (unsigned)i * 32u * (unsigned)ldb));
  }
  ag += 64; bg += 64;
#pragma unroll
  for (int i = 0; i < 4; ++i) {
    ra1[i] = *(const u32x4*)(ag + (ao + (unsigned)i * 32u * (unsigned)lda));
    rb1[i] = *(const u32x4*)(bg + (bo + (unsigned)i * 32u * (unsigned)ldb));
  }
  const int nk = K >> 6;
  const int wofs = (tid >> 3) * LSTR + (tid & 7) * 8;
#define DEEP_HALF(RA, RB, BUF, KT)                                                                       \
  {                                                                                                      \
    h16* sa = sm + (BUF) * (2 * 128 * LSTR);                                                             \
    h16* sb = sa + 128 * LSTR;                                                                           \
    _Pragma("unroll") for (int i = 0; i < 4; ++i) {                                                      \
      *(u32x4*)(sa + wofs + i * 32 * LSTR) = RA[i];                                                      \
      *(u32x4*)(sb + wofs + i * 32 * LSTR) = RB[i];                                                      \
    }                                                                                                    \
    __syncthreads();                                                                                     \
    const h16* pa = sa + (wm * 64 + r) * LSTR + hh * 8;                                                  \
    const h16* pb = sb + (wn * 64 + r) * LSTR + hh * 8;                                                  \
    h16x8 fa[2][2], fb[2][2];                                                                            \
    fa[0][0] = *(const h16x8*)(pa); fa[0][1] = *(const h16x8*)(pa + 32 * LSTR);                          \
    fb[0][0] = *(const h16x8*)(pb); fb[0][1] = *(const h16x8*)(pb + 32 * LSTR);                          \
    __builtin_amdgcn_sched_barrier(0);                                                                   \
    if ((KT) + 2 < nk) {                                                                                 \
      ag += 64; bg += 64;                                                                                \
      _Pragma("unroll") for (int i = 0; i < 4; ++i) {                                                    \
        RA[i] = *(const u32x4*)(ag + (ao + (unsigned)i * 32u * (unsigned)lda));                          \
        RB[i] = *(const u32x4*)(bg + (bo + (unsigned)i * 32u * (unsigned)ldb));                          \
      }                                                                                                  \
    }                                                                                                    \
    __builtin_amdgcn_sched_barrier(0);                                                                   \
    _Pragma("unroll") for (int ks = 0; ks < 4; ++ks) {                                                   \
      const int cur = ks & 1, nxt = cur ^ 1;                                                             \
      if (ks < 3) {                                                                                      \
        fa[nxt][0] = *(const h16x8*)(pa + (ks + 1) * 16); fa[nxt][1] = *(const h16x8*)(pa + 32 * LSTR + (ks + 1) * 16); \
        fb[nxt][0] = *(const h16x8*)(pb + (ks + 1) * 16); fb[nxt][1] = *(const h16x8*)(pb + 32 * LSTR + (ks + 1) * 16); \
      }                                                                                                  \
      acc[0][0] = MFMA(fa[cur][0], fb[cur][0], acc[0][0]);                                               \
      acc[0][1] = MFMA(fa[cur][0], fb[cur][1], acc[0][1]);                                               \
      acc[1][0] = MFMA(fa[cur][1], fb[cur][0], acc[1][0]);                                               \
      acc[1][1] = MFMA(fa[cur][1], fb[cur][1], acc[1][1]);                                               \
      __builtin_amdgcn_sched_barrier(0);                                                                 \
    }                                                                                                    \
  }
  for (int kt = 0; kt < nk; kt += 2) {
    DEEP_HALF(ra0, rb0, 0, kt)
    DEEP_HALF(ra1, rb1, 1, kt + 1)
  }
#undef DEEP_HALF
  __syncthreads();
}
DI void gemm_tile_c(const h16* __restrict__ A, int lda, const h16* __restrict__ B, int ldb, int K, f32x16 (&acc)[2][2], h16* sm,
                    u32x4 (&ra)[4], u32x4 (&rb)[4], bool pre, const h16* __restrict__ nA, int nlda, const h16* __restrict__ nB, int nldb) {
  const int tid = TIDX(), lane = tid & 63, w = tid >> 6, wm = w >> 1, wn = w & 1, r = lane & 31, hh = lane >> 5;
  const unsigned ao = (unsigned)(tid >> 3) * (unsigned)lda + (unsigned)(tid & 7) * 8u;
  const unsigned bo = (unsigned)(tid >> 3) * (unsigned)ldb + (unsigned)(tid & 7) * 8u;
  const h16* ag = A;
  const h16* bg = B;
  if (!pre) {
#pragma unroll
    for (int i = 0; i < 4; ++i) {
      ra[i] = *(const u32x4*)(ag + (ao + (unsigned)i * 32u * (unsigned)lda));
      rb[i] = *(const u32x4*)(bg + (bo + (unsigned)i * 32u * (unsigned)ldb));
    }
  }
  const int nk = K >> 6;
  const int wofs = (tid >> 3) * LSTR + (tid & 7) * 8;
  for (int kt = 0; kt < nk; ++kt) {
    h16* sa = sm + (kt & 1) * (2 * 128 * LSTR);
    h16* sb = sa + 128 * LSTR;
#pragma unroll
    for (int i = 0; i < 4; ++i) {
      *(u32x4*)(sa + wofs + i * 32 * LSTR) = ra[i];
      *(u32x4*)(sb + wofs + i * 32 * LSTR) = rb[i];
    }
    __syncthreads();
    const h16* pa = sa + (wm * 64 + r) * LSTR + hh * 8;
    const h16* pb = sb + (wn * 64 + r) * LSTR + hh * 8;
    h16x8 fa[2][2], fb[2][2];
    fa[0][0] = *(const h16x8*)(pa); fa[0][1] = *(const h16x8*)(pa + 32 * LSTR);
    fb[0][0] = *(const h16x8*)(pb); fb[0][1] = *(const h16x8*)(pb + 32 * LSTR);
    __builtin_amdgcn_sched_barrier(0);
    if (kt + 1 < nk) {
      ag += 64; bg += 64;
#pragma unroll
      for (int i = 0; i < 4; ++i) {
        ra[i] = *(const u32x4*)(ag + (ao + (unsigned)i * 32u * (unsigned)lda));
        rb[i] = *(const u32x4*)(bg + (bo + (unsigned)i * 32u * (unsigned)ldb));
      }
    } else if (nA != nullptr) {
      const unsigned nao = (unsigned)(tid >> 3) * (unsigned)nlda + (unsigned)(tid & 7) * 8u;
      const unsigned nbo = (unsigned)(tid >> 3) * (unsigned)nldb + (unsigned)(tid & 7) * 8u;
#pragma unroll
      for (int i = 0; i < 4; ++i) {
        ra[i] = *(const u32x4*)(nA + (nao + (unsigned)i * 32u * (unsigned)nlda));
        rb[i] = *(const u32x4*)(nB + (nbo + (unsigned)i * 32u * (unsigned)nldb));
      }
    }
    __builtin_amdgcn_sched_barrier(0);
#pragma unroll
    for (int ks = 0; ks < 4; ++ks) {
      const int cur = ks & 1, nxt = cur ^ 1;
      if (ks < 3) {
        fa[nxt][0] = *(const h16x8*)(pa + (ks + 1) * 16); fa[nxt][1] = *(const h16x8*)(pa + 32 * LSTR + (ks + 1) * 16);
        fb[nxt][0] = *(const h16x8*)(pb + (ks + 1) * 16); fb[nxt][1] = *(const h16x8*)(pb + 32 * LSTR + (ks + 1) * 16);
      }
      acc[0][0] = MFMA(fa[cur][0], fb[cur][0], acc[0][0]);
      acc[0][1] = MFMA(fa[cur][0], fb[cur][1], acc[0][1]);
      acc[1][0] = MFMA(fa[cur][1], fb[cur][0], acc[1][0]);
      acc[1][1] = MFMA(fa[cur][1], fb[cur][1], acc[1][1]);
      __builtin_amdgcn_sched_barrier(0);
    }
  }
  __syncthreads();
}
DI void zero_acc(f32x16 (&acc)[2][2]) {
#pragma unroll
  for (int a = 0; a < 2; ++a)
#pragma unroll
    for (int b = 0; b < 2; ++b)
#pragma unroll
      for (int i = 0; i < 16; ++i) acc[a][b][i] = 0.f;
}
constexpr int LS2 = 40;
template <class BR>
DI void gemm_tile_w(const h16* __restrict__ A, int lda, const h16* __restrict__ B, int ldb, BR brow, int K, f32x16 (&acc)[4][2], h16* sm) {
  const int tid = TIDX(), lane = tid & 63, w = tid >> 6, wm = w >> 1, wn = w & 1, r = lane & 31, hh = lane >> 5;
  const unsigned ao = (unsigned)(tid >> 2) * (unsigned)lda + (unsigned)(tid & 3) * 8u;
  const unsigned bo0 = (unsigned)brow(tid >> 2) * (unsigned)ldb + (unsigned)(tid & 3) * 8u;
  const unsigned bo1 = (unsigned)brow((tid >> 2) + 64) * (unsigned)ldb + (unsigned)(tid & 3) * 8u;
  const h16* ag = A;
  const h16* bg = B;
  u32x4 ra0[4], rb0[2], ra1[4], rb1[2];
#pragma unroll
  for (int i = 0; i < 4; ++i) ra0[i] = *(const u32x4*)(ag + (ao + (unsigned)i * 64u * (unsigned)lda));
  rb0[0] = *(const u32x4*)(bg + bo0);
  rb0[1] = *(const u32x4*)(bg + bo1);
  ag += 32; bg += 32;
#pragma unroll
  for (int i = 0; i < 4; ++i) ra1[i] = *(const u32x4*)(ag + (ao + (unsigned)i * 64u * (unsigned)lda));
  rb1[0] = *(const u32x4*)(bg + bo0);
  rb1[1] = *(const u32x4*)(bg + bo1);
  const int nk = K >> 5;
  const int wofs = (tid >> 2) * LS2 + (tid & 3) * 8;
#define WIDE_HALF(RA, RB, BUF, KT)                                                                       \
  {                                                                                                      \
    h16* sa = sm + (BUF) * (384 * LS2);                                                                  \
    h16* sb = sa + 256 * LS2;                                                                            \
    _Pragma("unroll") for (int i = 0; i < 4; ++i) *(u32x4*)(sa + wofs + i * 64 * LS2) = RA[i];           \
    *(u32x4*)(sb + wofs) = RB[0];                                                                        \
    *(u32x4*)(sb + wofs + 64 * LS2) = RB[1];                                                             \
    __syncthreads();                                                                                     \
    const h16* pa = sa + (wm * 128 + r) * LS2 + hh * 8;                                                  \
    const h16* pb = sb + (wn * 64 + r) * LS2 + hh * 8;                                                   \
    h16x8 fa0[4], fb0[2], fa1[4], fb1[2];                                                                \
    _Pragma("unroll") for (int mi = 0; mi < 4; ++mi) fa0[mi] = *(const h16x8*)(pa + mi * 32 * LS2);      \
    fb0[0] = *(const h16x8*)(pb); fb0[1] = *(const h16x8*)(pb + 32 * LS2);                               \
    __builtin_amdgcn_sched_barrier(0);                                                                   \
    if ((KT) + 2 < nk) {                                                                                 \
      ag += 32; bg += 32;                                                                                \
      _Pragma("unroll") for (int i = 0; i < 4; ++i) RA[i] = *(const u32x4*)(ag + (ao + (unsigned)i * 64u * (unsigned)lda)); \
      RB[0] = *(const u32x4*)(bg + bo0);                                                                 \
      RB[1] = *(const u32x4*)(bg + bo1);                                                                 \
    }                                                                                                    \
    __builtin_amdgcn_sched_barrier(0);                                                                   \
    _Pragma("unroll") for (int mi = 0; mi < 4; ++mi) fa1[mi] = *(const h16x8*)(pa + mi * 32 * LS2 + 16); \
    fb1[0] = *(const h16x8*)(pb + 16); fb1[1] = *(const h16x8*)(pb + 32 * LS2 + 16);                     \
    _Pragma("unroll") for (int mi = 0; mi < 4; ++mi) {                                                   \
      acc[mi][0] = MFMA(fa0[mi], fb0[0], acc[mi][0]);                                                    \
      acc[mi][1] = MFMA(fa0[mi], fb0[1], acc[mi][1]);                                                    \
    }                                                                                                    \
    __builtin_amdgcn_sched_barrier(0);                                                                   \
    _Pragma("unroll") for (int mi = 0; mi < 4; ++mi) {                                                   \
      acc[mi][0] = MFMA(fa1[mi], fb1[0], acc[mi][0]);                                                    \
      acc[mi][1] = MFMA(fa1[mi], fb1[1], acc[mi][1]);                                                    \
    }                                                                                                    \
    __builtin_amdgcn_sched_barrier(0);                                                                   \
  }
  for (int kt = 0; kt < nk; kt += 2) {
    WIDE_HALF(ra0, rb0, 0, kt)
    WIDE_HALF(ra1, rb1, 1, kt + 1)
  }
#undef WIDE_HALF
  __syncthreads();
}
DI void zero_acc_w(f32x16 (&acc)[4][2]) {
#pragma unroll
  for (int a = 0; a < 4; ++a)
#pragma unroll
    for (int b = 0; b < 2; ++b)
#pragma unroll
      for (int i = 0; i < 16; ++i) acc[a][b][i] = 0.f;
}
template <class F>
DI void epi_foreach_w(f32x16 (&acc)[4][2], int m0, int n0, F f) {
  const int lane = TIDX() & 63, w = TIDX() >> 6, wm = w >> 1, wn = w & 1, hh = lane >> 5, c = lane & 31;
#pragma unroll
  for (int mi = 0; mi < 4; ++mi)
#pragma unroll
    for (int ni = 0; ni < 2; ++ni) {
      int rb = m0 + wm * 128 + mi * 32 + 4 * hh;
      asm volatile("" : "+v"(rb));
      f(rb, n0 + wn * 64 + ni * 32 + c, acc[mi][ni]);
    }
}
#define XCD_LOOP_W(Mt, ntn) const int xcd_ = BIDX() & 7; const int Mx_ = ((Mt) + 7) >> 3; for (int u_ = BIDX() >> 3; u_ < Mx_ * (ntn); u_ += (int)(gridDim.x >> 3))
template <class F>
DI void epi_foreach(f32x16 (&acc)[2][2], int m0, int n0, F f) {
  const int lane = TIDX() & 63, w = TIDX() >> 6, wm = w >> 1, wn = w & 1, hh = lane >> 5, c = lane & 31;
#pragma unroll
  for (int mi = 0; mi < 2; ++mi)
#pragma unroll
    for (int ni = 0; ni < 2; ++ni) f(m0 + wm * 64 + mi * 32 + 4 * hh, n0 + wn * 64 + ni * 32 + c, acc[mi][ni]);
}
DI void tile_map(int u, int Mx, int ntn, int x, int& mt, int& nt) {
  const int sr = u / (8 * ntn);
  const int rows = min(8, Mx - sr * 8);
  const int v = u - sr * 8 * ntn;
  nt = v / rows;
  mt = x * Mx + sr * 8 + (v - nt * rows);
}
#define XCD_LOOP(Mx, ntn) const int xcd_ = BIDX() & 7; for (int u_ = BIDX() >> 3; u_ < (Mx) * (ntn); u_ += (int)(gridDim.x >> 3))
#define EROW(rbase, reg) ((rbase) + ((reg) & 3) + 8 * ((reg) >> 2))

DI void convT(const float* __restrict__ src, int K, int N, h16* __restrict__ dst, float* tile) {
  const int tid = TIDX(), tx = tid & 31, ty = tid >> 5;
  const int tn = N >> 5, nt = (K >> 5) * tn;
  for (int t = BIDX(); t < nt; t += gridDim.x) {
    const int k0 = (t / tn) * 32, n0 = (t % tn) * 32;
#pragma unroll
    for (int i = 0; i < 4; ++i) tile[(ty + 8 * i) * 33 + tx] = src[(size_t)(k0 + ty + 8 * i) * N + n0 + tx];
    __syncthreads();
#pragma unroll
    for (int i = 0; i < 4; ++i) dst[(size_t)(n0 + ty + 8 * i) * K + k0 + tx] = (h16)tile[tx * 33 + ty + 8 * i];
    __syncthreads();
  }
}
DI void conv_weights(const P& p, int l, char* smem) {
  h16* W = (h16*)(p.ws + OFF_W16);
  float* tile = (float*)smem;
  convT(p.in[I_WIN] + (size_t)l * 1024 * 6432, 1024, 6432, W + WO_WIN, tile);
  convT(p.in[I_WUQ] + (size_t)l * 384 * 768, 384, 768, W + WO_UQ, tile);
  convT(p.in[I_WUKV] + (size_t)l * 256 * 1024, 256, 1024, W + WO_UKV, tile);
  convT(p.in[I_G2] + (size_t)l * 128 * 512, 128, 512, W + WO_G2, tile);
  for (int n = 0; n < 3; ++n) convT(p.in[I_WB] + ((size_t)l * 3 + n) * 512 * 1024, 512, 1024, W + WO_WB + (size_t)n * 1024 * 512, tile);
  convT(p.in[I_WOUT] + (size_t)l * 1024 * 1024, 1024, 1024, W + WO_WOUT, tile);
  convT(p.in[I_FIN] + (size_t)l * 1024 * 5632, 1024, 5632, W + WO_FIN, tile);
  convT(p.in[I_FOUT] + (size_t)l * 2816 * 1024, 2816, 1024, W + WO_FOUT, tile);
}

DI void phase_init(const P& p, char* smem) {
  const int tid = TIDX();
  float* mod = (float*)(p.ws + OFF_MOD);
  for (int it = BIDX(); it < 192; it += gridDim.x) {
    const int l = it / 96, n0 = (it % 96) * 64;
    float* s = (float*)smem;
    for (int i = tid; i < 9 * 1024; i += 256) {
      int r = i >> 10, k = i & 1023;
      float v = r < 8 ? p.in[I_C][r * 1024 + k] : p.in[I_CCTX][k];
      s[i] = v / (1.f + expf(-v));
    }
    __syncthreads();
    const int col = tid & 63, kq = tid >> 6;
    float a0 = 0, a1 = 0, a2 = 0, a3 = 0, a4 = 0, a5 = 0, a6 = 0, a7 = 0, a8 = 0;
    const float* wp = p.in[I_ADAW] + (size_t)l * 1024 * 6144 + n0 + col;
    for (int k0 = kq * 256; k0 < kq * 256 + 256; k0 += 16) {
      float wvv[16];
#pragma unroll
      for (int u = 0; u < 16; ++u) wvv[u] = wp[(size_t)(k0 + u) * 6144];
#pragma unroll
      for (int u = 0; u < 16; ++u) {
        const int k = k0 + u;
        const float wv = wvv[u];
        a0 += s[k] * wv; a1 += s[1024 + k] * wv; a2 += s[2048 + k] * wv; a3 += s[3072 + k] * wv; a4 += s[4096 + k] * wv;
        a5 += s[5120 + k] * wv; a6 += s[6144 + k] * wv; a7 += s[7168 + k] * wv; a8 += s[8192 + k] * wv;
      }
    }
    float* red = s + 9 * 1024;
    red[(kq * 9 + 0) * 64 + col] = a0; red[(kq * 9 + 1) * 64 + col] = a1; red[(kq * 9 + 2) * 64 + col] = a2;
    red[(kq * 9 + 3) * 64 + col] = a3; red[(kq * 9 + 4) * 64 + col] = a4; red[(kq * 9 + 5) * 64 + col] = a5;
    red[(kq * 9 + 6) * 64 + col] = a6; red[(kq * 9 + 7) * 64 + col] = a7; red[(kq * 9 + 8) * 64 + col] = a8;
    __syncthreads();
    for (int i = tid; i < 9 * 64; i += 256) {
      int r = i >> 6, cc = i & 63;
      float v = red[(0 * 9 + r) * 64 + cc] + red[(1 * 9 + r) * 64 + cc] + red[(2 * 9 + r) * 64 + cc] + red[(3 * 9 + r) * 64 + cc];
      mod[((size_t)l * 9 + r) * 6144 + n0 + cc] = v + p.in[I_ADAB][(size_t)l * 6144 + n0 + cc];
    }
    __syncthreads();
  }
  f32x2* rm = (f32x2*)(p.ws + OFF_ROPEM);
  f32x2* rg = (f32x2*)(p.ws + OFF_ROPEG);
  for (int i = BIDX() * 256 + tid; i < 4096 * 48; i += gridDim.x * 256) {
    int t = i / 48, j = i % 48;
    float rowi = (float)(t >> 6), coli = (float)(t & 63);
    if (j < 16) {
      int q = j & 7;
      float f = exp2f(-(float)q / 8.f * 13.287712379549449f);
      float ang = (j < 8 ? rowi : coli) * f;
      f32x2 cs; cs.x = cosf(ang); cs.y = sinf(ang);
      rm[t * 16 + j] = cs;
    } else {
      int jj = j - 16, q = jj & 15;
      float f = exp2f(-(float)q / 16.f * 13.287712379549449f);
      float ang = (jj < 16 ? rowi : coli) * f;
      f32x2 cs; cs.x = cosf(ang); cs.y = sinf(ang);
      rg[t * 32 + jj] = cs;
    }
  }
  if (BIDX() == 0 && TIDX() < 64) ((int*)(p.ws + OFF_CTR))[TIDX()] = 0;
  conv_weights(p, 0, smem);
}

DI void rows_norm_mod(const P& p, const float* xlat, const float* xctx, int l, const float* gain, int sh_idx, int sc_idx,
                      h16* dst, int nrows) {
  const int lane = TIDX() & 63;
  const int gw = BIDX() * 4 + (TIDX() >> 6), nw = gridDim.x * 4;
  const float* mod = (const float*)(p.ws + OFF_MOD);
  for (int row = gw; row < nrows; row += nw) {
    const float* xr = row < TL ? xlat + (size_t)row * 1024 : xctx + (size_t)(row - TL) * 1024;
    const int mrow = row < TL ? (row >> 12) : 8;
    const float* mr = mod + ((size_t)l * 9 + mrow) * 6144;
    f32x4 v[4];
    float ss = 0.f;
#pragma unroll
    for (int i = 0; i < 4; ++i) {
      v[i] = *(const f32x4*)(xr + lane * 4 + 256 * i);
      ss += v[i].x * v[i].x + v[i].y * v[i].y + v[i].z * v[i].z + v[i].w * v[i].w;
    }
    ss = wave_sum(ss);
    const float rstd = rsqrtf(ss * (1.f / 1024.f) + EPS);
#pragma unroll
    for (int i = 0; i < 4; ++i) {
      const int c = lane * 4 + 256 * i;
      f32x4 g = *(const f32x4*)(gain + c), sc = *(const f32x4*)(mr + sc_idx * 1024 + c), sh = *(const f32x4*)(mr + sh_idx * 1024 + c);
      h16x4 o;
      o.x = (h16)(v[i].x * rstd * g.x * (1.f + sc.x) + sh.x);
      o.y = (h16)(v[i].y * rstd * g.y * (1.f + sc.y) + sh.y);
      o.z = (h16)(v[i].z * rstd * g.z * (1.f + sc.z) + sh.z);
      o.w = (h16)(v[i].w * rstd * g.w * (1.f + sc.w) + sh.w);
      *(h16x4*)(dst + (size_t)row * 1024 + c) = o;
    }
  }
}

DI void rows_resid_norm(const P& p, const float* xlat, const float* xctx, const h16* y, int l, int gate_idx, const float* post_g,
                        bool do_next, int l2, const float* gain2, int sh_idx, int sc_idx, h16* dst, int nrows) {
  const int lane = TIDX() & 63;
  const int gw = BIDX() * 4 + (TIDX() >> 6), nw = gridDim.x * 4;
  const float* mod = (const float*)(p.ws + OFF_MOD);
  float* xc = (float*)(p.ws + OFF_XC);
  for (int row = gw; row < nrows; row += nw) {
    const float* xr = row < TL ? xlat + (size_t)row * 1024 : xctx + (size_t)(row - TL) * 1024;
    float* xo = row < TL ? p.out + (size_t)row * 1024 : xc + (size_t)(row - TL) * 1024;
    const int mrow = row < TL ? (row >> 12) : 8;
    const float* mr = mod + ((size_t)l * 9 + mrow) * 6144;
    const float* mr2 = mod + ((size_t)l2 * 9 + mrow) * 6144;
    f32x4 yv[4], xv[4];
    float ss = 0.f;
#pragma unroll
    for (int i = 0; i < 4; ++i) {
      h16x4 t = *(const h16x4*)(y + (size_t)row * 1024 + lane * 4 + 256 * i);
      yv[i].x = (float)t.x; yv[i].y = (float)t.y; yv[i].z = (float)t.z; yv[i].w = (float)t.w;
      ss += yv[i].x * yv[i].x + yv[i].y * yv[i].y + yv[i].z * yv[i].z + yv[i].w * yv[i].w;
      xv[i] = *(const f32x4*)(xr + lane * 4 + 256 * i);
    }
    ss = wave_sum(ss);
    const float rstd = rsqrtf(ss * (1.f / 1024.f) + EPS);
    float s2 = 0.f;
#pragma unroll
    for (int i = 0; i < 4; ++i) {
      const int c = lane * 4 + 256 * i;
      f32x4 g = *(const f32x4*)(post_g + c), gt = *(const f32x4*)(mr + gate_idx * 1024 + c);
      xv[i].x += gt.x * (yv[i].x * rstd * g.x);
      xv[i].y += gt.y * (yv[i].y * rstd * g.y);
      xv[i].z += gt.z * (yv[i].z * rstd * g.z);
      xv[i].w += gt.w * (yv[i].w * rstd * g.w);
      *(f32x4*)(xo + c) = xv[i];
      s2 += xv[i].x * xv[i].x + xv[i].y * xv[i].y + xv[i].z * xv[i].z + xv[i].w * xv[i].w;
    }
    if (do_next) {
      s2 = wave_sum(s2);
      const float r2 = rsqrtf(s2 * (1.f / 1024.f) + EPS);
#pragma unroll
      for (int i = 0; i < 4; ++i) {
        const int c = lane * 4 + 256 * i;
        f32x4 g = *(const f32x4*)(gain2 + c), sc = *(const f32x4*)(mr2 + sc_idx * 1024 + c), sh = *(const f32x4*)(mr2 + sh_idx * 1024 + c);
        h16x4 o;
        o.x = (h16)(xv[i].x * r2 * g.x * (1.f + sc.x) + sh.x);
        o.y = (h16)(xv[i].y * r2 * g.y * (1.f + sc.y) + sh.y);
        o.z = (h16)(xv[i].z * r2 * g.z * (1.f + sc.z) + sh.z);
        o.w = (h16)(xv[i].w * r2 * g.w * (1.f + sc.w) + sh.w);
        *(h16x4*)(dst + (size_t)row * 1024 + c) = o;
      }
    }
  }
}

DI void phase_proj(const P& p, int l, char* smem) {
  const h16* W = (const h16*)(p.ws + OFF_W16) + WO_WIN;
  const h16* hbuf = (const h16*)(p.ws + OFF_HB);
  h16* cqkv = (h16*)(p.ws + OFF_X);
  h16* krot = (h16*)(p.ws + OFF_KROT);
  h16* Qg = (h16*)(p.ws + OFF_QG);
  h16* Kg = (h16*)(p.ws + OFF_KG);
  h16* VgT = (h16*)(p.ws + OFF_VGT);
  h16* rkv = (h16*)(p.ws + OFF_R1);
  h16* lora = rkv + (size_t)TA * 1536;
  XCD_LOOP_W(136, 27) {
    int mt_, nt_;
    tile_map(u_, Mx_, 27, xcd_, mt_, nt_);
    if (mt_ >= 136) continue;
    const int m0 = mt_ * 256, n0 = nt_ * 128;
    f32x16 acc[4][2];
    zero_acc_w(acc);
    gemm_tile_w(hbuf + (size_t)m0 * 1024, 1024, W, 1024, [&](int rr) { return n0 + rr; }, 1024, acc, (h16*)smem);
    epi_foreach_w(acc, m0, n0, [&](int rbase, int n, const f32x16& v) {
      const int nb = n & ~31;
      if (nb >= 3360) return;
      const int b = rbase < TL ? (rbase >> 12) : ((rbase - TL) >> 8);
      const int srb = srow_of(rbase);
      if (nb < 640) {
#pragma unroll
        for (int i = 0; i < 16; ++i) cqkv[(size_t)EROW(rbase, i) * 640 + n] = (h16)v[i];
      } else if (nb < 672) {
#pragma unroll
        for (int i = 0; i < 16; ++i) krot[(size_t)EROW(srb, i) * 32 + (n - 640)] = (h16)v[i];
      } else if (nb < 1184) {
        const int hq = (n - 672) >> 6, d = (n - 672) & 63;
        h16* q = Qg + (size_t)hq * SA * 64 + d;
#pragma unroll
        for (int i = 0; i < 16; ++i) q[((size_t)EROW(srb, i) + (size_t)b * 7 * SA) * 64] = (h16)v[i];
      } else if (nb < 1312) {
        const int kh = (n - 1184) >> 6, d = (n - 1184) & 63;
        h16* k = Kg + (size_t)kh * SA * 64 + d;
#pragma unroll
        for (int i = 0; i < 16; ++i) k[((size_t)EROW(srb, i) + (size_t)b * SA) * 64] = (h16)v[i];
      } else if (nb < 1440) {
        const int kh = (n - 1312) >> 6, d = (n - 1312) & 63;
        const int s = srb - b * SA;
        h16* vt = VgT + ((size_t)(b * 2 + kh) * 64 + d) * SA + s;
#pragma unroll
        for (int g = 0; g < 4; ++g) {
          h16x4 o; o.x = (h16)v[4 * g]; o.y = (h16)v[4 * g + 1]; o.z = (h16)v[4 * g + 2]; o.w = (h16)v[4 * g + 3];
          *(h16x4*)(vt + 8 * g) = o;
        }
      } else if (nb < 2976) {
#pragma unroll
        for (int i = 0; i < 16; ++i) rkv[(size_t)EROW(rbase, i) * 1536 + (n - 1440)] = (h16)v[i];
      } else {
        const int j = n - 2976;
#pragma unroll
        for (int i = 0; i < 16; ++i) {
          float x = v[i];
          if (j < 128) x = tanhf(x);
          else if (j >= 256) x = sigmoidf_(x);
          lora[(size_t)EROW(rbase, i) * 384 + j] = (h16)x;
        }
      }
    });
  }
}

DI void phase_prep(const P& p, int l, int boff, int geff) {
  const int lane = TIDX() & 63;
  const int gw = (BIDX() - boff) * 4 + (TIDX() >> 6), nw = geff * 4;
  h16* cqkv = (h16*)(p.ws + OFF_X);
  h16* krot = (h16*)(p.ws + OFF_KROT);
  h16* Qg = (h16*)(p.ws + OFF_QG);
  h16* Kg = (h16*)(p.ws + OFF_KG);
  const f32x2* rm = (const f32x2*)(p.ws + OFF_ROPEM);
  const f32x2* rg = (const f32x2*)(p.ws + OFF_ROPEG);
  const float* qn = p.in[I_QNORM] + l * 384;
  const float* kvn = p.in[I_KVNORM] + l * 256;
  const float gq = p.in[I_GQN][l * 64 + lane], gk = p.in[I_GKN][l * 64 + lane];
  for (int row = gw; row < TA; row += nw) {
    const bool lat = row < TL;
    const int b = lat ? (row >> 12) : ((row - TL) >> 8);
    const int srow = srow_of(row);
    const int tpos = row & 4095;
    {
      h16* cq = cqkv + (size_t)row * 640;
      float x[6], ss = 0.f;
#pragma unroll
      for (int i = 0; i < 6; ++i) { x[i] = (float)cq[lane + 64 * i]; ss += x[i] * x[i]; }
      ss = wave_sum(ss);
      float rstd = rsqrtf(ss * (1.f / 384.f) + EPS);
#pragma unroll
      for (int i = 0; i < 6; ++i) cq[lane + 64 * i] = (h16)(x[i] * rstd * qn[lane + 64 * i]);
      h16* ck = cq + 384;
      float y[4]; ss = 0.f;
#pragma unroll
      for (int i = 0; i < 4; ++i) { y[i] = (float)ck[lane + 64 * i]; ss += y[i] * y[i]; }
      ss = wave_sum(ss);
      rstd = rsqrtf(ss * (1.f / 256.f) + EPS);
#pragma unroll
      for (int i = 0; i < 4; ++i) ck[lane + 64 * i] = (h16)(y[i] * rstd * kvn[lane + 64 * i]);
    }
    if (lat && lane < 16) {
      h16* kr = krot + (size_t)srow * 32;
      float x1 = (float)kr[lane], x2 = (float)kr[lane + 16];
      f32x2 cs = rm[tpos * 16 + lane];
      kr[lane] = (h16)(x1 * cs.x - x2 * cs.y);
      kr[lane + 16] = (h16)(x1 * cs.y + x2 * cs.x);
    }
    f32x2 cs; cs.x = 1.f; cs.y = 0.f;
    if (lat) cs = rg[tpos * 32 + (lane & 31)];
#pragma unroll
    for (int hq = 0; hq < 8; ++hq) {
      h16* q = Qg + ((size_t)(b * 8 + hq) * SA + (srow - b * SA)) * 64;
      float x = (float)q[lane];
      float ss = wave_sum(x * x);
      x = x * rsqrtf(ss * (1.f / 64.f) + EPS) * gq;
      float o = shx(x, 32);
      float rr = lane < 32 ? (x * cs.x - o * cs.y) : (o * cs.y + x * cs.x);
      q[lane] = (h16)(rr * (0.125f * LOG2E));
    }
#pragma unroll
    for (int kh = 0; kh < 2; ++kh) {
      h16* k = Kg + ((size_t)(b * 2 + kh) * SA + (srow - b * SA)) * 64;
      float x = (float)k[lane];
      float ss = wave_sum(x * x);
      x = x * rsqrtf(ss * (1.f / 64.f) + EPS) * gk;
      float o = shx(x, 32);
      float rr = lane < 32 ? (x * cs.x - o * cs.y) : (o * cs.y + x * cs.x);
      k[lane] = (h16)rr;
    }
  }
}

DI void phase_uproj(const P& p, int l, char* smem, int boff, int geff) {
  const h16* W = (const h16*)(p.ws + OFF_W16);
  const h16* cqkv = (const h16*)(p.ws + OFF_X);
  h16* Qm = (h16*)(p.ws + OFF_QM);
  h16* kn = (h16*)(p.ws + OFF_KN);
  h16* VmT = (h16*)(p.ws + OFF_VMT);
  const f32x2* rm = (const f32x2*)(p.ws + OFF_ROPEM);
  const float qscale = 0.10206207261596575f * LOG2E;
  const int be_ = BIDX() - boff;
  const int xcd_ = be_ & 7;
  const int Mx_ = (136 + 7) >> 3;
  for (int u_ = be_ >> 3; u_ < Mx_ * 14; u_ += (geff >> 3)) {
    int mt_, nn;
    tile_map(u_, Mx_, 14, xcd_, mt_, nn);
    if (mt_ >= 136) continue;
    const int m0 = mt_ * 256;
    f32x16 acc[4][2];
    zero_acc_w(acc);
    if (nn < 6) {
      const int n0 = nn * 128;
      gemm_tile_w(cqkv + (size_t)m0 * 640, 640, W + WO_UQ, 384, [&](int rr) { return n0 + rr; }, 384, acc, (h16*)smem);
      epi_foreach_w(acc, m0, n0, [&](int rbase, int n, const f32x16& v) {
        const int b = rbase < TL ? (rbase >> 12) : ((rbase - TL) >> 8);
        const int srb = srow_of(rbase);
        const int head = n / 96, dd = n - head * 96;
        h16* q = Qm + ((size_t)(b * 7 + head) * SA) * 96 + dd;
        if (dd < 64 || rbase >= TL) {
#pragma unroll
          for (int i = 0; i < 16; ++i) q[(size_t)EROW(srb, i) * 96] = (h16)(v[i] * qscale);
        } else {
          const int ii = dd - 64;
#pragma unroll
          for (int i = 0; i < 16; ++i) {
            float x = v[i];
            float o = shx(x, 16);
            f32x2 cs = rm[(EROW(rbase, i) & 4095) * 16 + (ii & 15)];
            float rr = ii < 16 ? (x * cs.x - o * cs.y) : (o * cs.y + x * cs.x);
            q[(size_t)EROW(srb, i) * 96] = (h16)(rr * qscale);
          }
        }
      });
    } else {
      const int n0 = (nn - 6) * 128;
      gemm_tile_w(cqkv + (size_t)m0 * 640 + 384, 640, W + WO_UKV, 256, [&](int rr) { return n0 + rr; }, 256, acc, (h16*)smem);
      epi_foreach_w(acc, m0, n0, [&](int rbase, int n, const f32x16& v) {
        const int b = rbase < TL ? (rbase >> 12) : ((rbase - TL) >> 8);
        const int srb = srow_of(rbase);
        const int head = n >> 7, dd = n & 127;
        if (dd < 64) {
          h16* k = kn + ((size_t)(b * 7 + head) * SA) * 64 + dd;
#pragma unroll
          for (int i = 0; i < 16; ++i) k[(size_t)EROW(srb, i) * 64] = (h16)v[i];
        } else {
          const int s = srb - b * SA;
          h16* vt = VmT + ((size_t)(b * 8 + head) * 64 + (dd - 64)) * SA + s;
#pragma unroll
          for (int g = 0; g < 4; ++g) {
            h16x4 o; o.x = (h16)v[4 * g]; o.y = (h16)v[4 * g + 1]; o.z = (h16)v[4 * g + 2]; o.w = (h16)v[4 * g + 3];
            *(h16x4*)(vt + 8 * g) = o;
          }
        }
      });
    }
  }
}

template <int DK, bool MLA>
DI void attn_item(const h16* __restrict__ Q, const h16* __restrict__ Kp, const h16* __restrict__ Kr, const h16* __restrict__ Vt,
                  int kbeg, int kend, h16* __restrict__ out, h16* sm) {
  constexpr int KS = DK + 8;
  constexpr int NKC = DK / 8;
  constexpr int NCH = 64 * NKC / 256;
  constexpr int BUF = 64 * KS + 64 * 72;
  const int tid = TIDX(), lane = tid & 63, w = tid >> 6, r = lane & 31, hh = lane >> 5;
  h16x8 qf[DK / 16];
  {
    const h16* qr = Q + (size_t)(w * 32 + r) * DK + hh * 8;
#pragma unroll
    for (int ks = 0; ks < DK / 16; ++ks) qf[ks] = *(const h16x8*)(qr + ks * 16);
  }
  f32x16 ot[2];
#pragma unroll
  for (int i = 0; i < 16; ++i) { ot[0][i] = 0.f; ot[1][i] = 0.f; }
  float m = -1000.f, lsum = 0.f;
  u32x4 rkA[NCH], rvA[2], rkB[NCH], rvB[2];
#define ATT_GLOAD(RK, RV, KB)                                                                            \
  {                                                                                                      \
    _Pragma("unroll") for (int i = 0; i < NCH; ++i) {                                                    \
      const int c = tid + 256 * i, key = c / NKC, part = c % NKC;                                        \
      if (MLA) {                                                                                         \
        if (part < 8) RK[i] = *(const u32x4*)(Kp + (size_t)((KB) + key) * 64 + part * 8);                \
        else RK[i] = *(const u32x4*)(Kr + (size_t)((KB) + key) * 32 + (part - 8) * 8);                   \
      } else {                                                                                           \
        RK[i] = *(const u32x4*)(Kp + (size_t)((KB) + key) * 64 + part * 8);                              \
      }                                                                                                  \
    }                                                                                                    \
    _Pragma("unroll") for (int i = 0; i < 2; ++i) {                                                      \
      const int c = tid + 256 * i, dv = c >> 3, kc = c & 7;                                              \
      RV[i] = *(const u32x4*)(Vt + (size_t)dv * SA + (KB) + kc * 8);                                     \
    }                                                                                                    \
  }
  const int ntile = (kend - kbeg) >> 6;
  ATT_GLOAD(rkA, rvA, kbeg)
  ATT_GLOAD(rkB, rvB, kbeg + 64)
  auto tile = [&](int it, u32x4 (&RK)[NCH], u32x4 (&RV)[2]) {
    h16* ksm = sm + (it & 1) * BUF;
    h16* vsm = ksm + 64 * KS;
#pragma unroll
    for (int i = 0; i < NCH; ++i) {
      const int c = tid + 256 * i, key = c / NKC, part = c % NKC;
      *(u32x4*)(ksm + key * KS + part * 8) = RK[i];
    }
#pragma unroll
    for (int i = 0; i < 2; ++i) {
      const int c = tid + 256 * i, dv = c >> 3, kc = c & 7;
      *(u32x4*)(vsm + dv * 72 + kc * 8) = RV[i];
    }
    __syncthreads();
    if (it + 2 < ntile) ATT_GLOAD(RK, RV, kbeg + (it + 2) * 64)
    f32x16 st[2];
    const float negm = -m;
#pragma unroll
    for (int i = 0; i < 16; ++i) { st[0][i] = negm; st[1][i] = negm; }
#pragma unroll
    for (int ks = 0; ks < DK / 16; ++ks) {
      h16x8 k0 = *(const h16x8*)(ksm + r * KS + ks * 16 + hh * 8);
      h16x8 k1 = *(const h16x8*)(ksm + (32 + r) * KS + ks * 16 + hh * 8);
      st[0] = MFMA(k0, qf[ks], st[0]);
      st[1] = MFMA(k1, qf[ks], st[1]);
    }
    float mx = fmaxf(st[0][0], st[1][0]);
#pragma unroll
    for (int i = 1; i < 16; ++i) mx = fmaxf(mx, fmaxf(st[0][i], st[1][i]));
    mx = x32_max(mx);
    if (__builtin_amdgcn_ballot_w64(mx > 8.f) != 0) {
      const float dlt = fmaxf(mx, 0.f);
      const float alpha = __builtin_amdgcn_exp2f(-dlt);
      m += dlt;
      lsum *= alpha;
#pragma unroll
      for (int i = 0; i < 16; ++i) { ot[0][i] *= alpha; ot[1][i] *= alpha; st[0][i] -= dlt; st[1][i] -= dlt; }
    }
    float ps = 0.f;
#pragma unroll
    for (int i = 0; i < 16; ++i) {
      st[0][i] = __builtin_amdgcn_exp2f(st[0][i]);
      st[1][i] = __builtin_amdgcn_exp2f(st[1][i]);
      ps += st[0][i] + st[1][i];
    }
    lsum += ps;
#pragma unroll
    for (int s4 = 0; s4 < 4; ++s4) {
      const int kt2 = s4 >> 1, hf = s4 & 1;
      h16x8 pb;
#pragma unroll
      for (int j = 0; j < 8; ++j) pb[j] = (h16)st[kt2][8 * hf + j];
      const int kb = kt2 * 32 + 16 * hf;
#pragma unroll
      for (int dt = 0; dt < 2; ++dt) {
        const h16* vp = vsm + (dt * 32 + r) * 72 + kb + 4 * hh;
        h16x4 lo = *(const h16x4*)vp, hi = *(const h16x4*)(vp + 8);
        h16x8 va = __builtin_shufflevector(lo, hi, 0, 1, 2, 3, 4, 5, 6, 7);
        ot[dt] = MFMA(va, pb, ot[dt]);
      }
    }
  };
  for (int it = 0; it < ntile; it += 2) {
    tile(it, rkA, rvA);
    tile(it + 1, rkB, rvB);
  }
#undef ATT_GLOAD
  __syncthreads();
  lsum = x32_sum(lsum);
  const float inv = 1.f / lsum;
  h16* orow = out + (size_t)(w * 32 + r) * 512;
#pragma unroll
  for (int dt = 0; dt < 2; ++dt)
#pragma unroll
    for (int g = 0; g < 4; ++g) {
      h16x4 o;
      o.x = (h16)(ot[dt][4 * g] * inv); o.y = (h16)(ot[dt][4 * g + 1] * inv);
      o.z = (h16)(ot[dt][4 * g + 2] * inv); o.w = (h16)(ot[dt][4 * g + 3] * inv);
      *(h16x4*)(orow + dt * 32 + 8 * g + 4 * hh) = o;
    }
}

DI void attn_dispatch(const P& p, int b, int it, char* smem) {
  const h16* Qm = (const h16*)(p.ws + OFF_QM);
  const h16* kn = (const h16*)(p.ws + OFF_KN);
  const h16* krot = (const h16*)(p.ws + OFF_KROT);
  const h16* VmT = (const h16*)(p.ws + OFF_VMT);
  const h16* Qg = (const h16*)(p.ws + OFF_QG);
  const h16* Kg = (const h16*)(p.ws + OFF_KG);
  const h16* VgT = (const h16*)(p.ws + OFF_VGT);
  h16* oa = (h16*)(p.ws + OFF_X);
  h16* ob = oa + (size_t)TA * 512;
  bool mla; int head, s0, kbeg, kend; size_t row0;
  if (it < 512) {
    mla = it < 256;
    head = (it >> 5) & 7; s0 = (it & 31) * 128; kbeg = 0; kend = SA;
    row0 = (size_t)b * 4096 + s0;
  } else {
    const int j = it - 512;
    mla = j < 16;
    head = (j >> 1) & 7; const int qb = j & 1;
    s0 = 4096 + qb * 128; kbeg = 4096; kend = SA;
    row0 = (size_t)TL + b * 256 + qb * 128;
  }
  if (mla) {
    attn_item<96, true>(Qm + ((size_t)(b * 8 + head) * SA + s0) * 96, kn + (size_t)(b * 8 + head) * SA * 64, krot + (size_t)b * SA * 32,
                        VmT + (size_t)(b * 8 + head) * 64 * SA, kbeg, kend, oa + row0 * 512 + head * 64, (h16*)smem);
  } else {
    attn_item<64, false>(Qg + ((size_t)(b * 8 + head) * SA + s0) * 64, Kg + (size_t)(b * 2 + (head >> 2)) * SA * 64, nullptr,
                         VgT + (size_t)(b * 2 + (head >> 2)) * 64 * SA, kbeg, kend, ob + row0 * 512 + head * 64, (h16*)smem);
  }
}
DI void scan_chain(const P& p, int l, int chain, int half, char* smem) {
  const int tid = TIDX(), lane = tid & 63, w = tid >> 6;
  const int d = chain >> 6, b = (chain >> 3) & 7, h = chain & 7;
  float* raw = (float*)smem;
  float* ckk = raw + 4096;
  float* cw = ckk + 2048; float* cb = cw + 2048; float* ck = cb + 2048; float* cr = ck + 2048; float* cv = cr + 2048;
  const h16* rkv = (const h16*)(p.ws + OFF_R1);
  const h16* lora = rkv + (size_t)TA * 1536;
  float* bs = (float*)(p.ws + OFF_BS);
  h16* so = (h16*)(p.ws + OFF_HB) + (size_t)d * TA * 512;
  const int mat = w & 1, nblk = w >> 1;
  h16x8 bf[4];
  {
    const float* wsrc = (mat ? p.in[I_A2] : p.in[I_W2]) + ((size_t)(l * 2 + d) * 64) * 512 + h * 64 + nblk * 32 + (lane & 31);
#pragma unroll
    for (int ks = 0; ks < 4; ++ks)
#pragma unroll
      for (int e = 0; e < 8; ++e) bf[ks][e] = (h16)wsrc[(size_t)(ks * 16 + 8 * (lane >> 5) + e) * 512];
  }
  const int c = h * 64 + lane;
  const float w0 = p.in[I_W0][(l * 2 + d) * 512 + c], a0 = p.in[I_A0][(l * 2 + d) * 512 + c];
  const float kkc = p.in[I_KK][l * 512 + c], kac = p.in[I_KA][l * 512 + c], rkc = p.in[I_RK][l * 512 + c];
  const float* cvp = p.in[I_CONV] + (size_t)l * 3 * 1536;
  const float trA = cvp[(d ? 3072 : 0) + c], tr1 = cvp[1536 + c], trC = cvp[(d ? 0 : 3072) + c];
  const float tkA = cvp[(d ? 3072 : 0) + 512 + c], tk1 = cvp[1536 + 512 + c], tkC = cvp[(d ? 0 : 3072) + 512 + c];
  const float tvA = cvp[(d ? 3072 : 0) + 1024 + c], tv1 = cvp[1536 + 1024 + c], tvC = cvp[(d ? 0 : 3072) + 1024 + c];
  f32x2 S[2][2];
#pragma unroll
  for (int e = 0; e < 2; ++e) { S[e][0].x = 0.f; S[e][0].y = 0.f; S[e][1].x = 0.f; S[e][1].y = 0.f; }
  const int rg = lane >> 4, jq = lane & 15;
  auto row16_sum = [](float v) -> float {
    v += __int_as_float(__builtin_amdgcn_mov_dpp(__float_as_int(v), 0xB1, 0xF, 0xF, true));
    v += __int_as_float(__builtin_amdgcn_mov_dpp(__float_as_int(v), 0x4E, 0xF, 0xF, true));
    v += __int_as_float(__builtin_amdgcn_mov_dpp(__float_as_int(v), 0x141, 0xF, 0xF, true));
    v += __int_as_float(__builtin_amdgcn_mov_dpp(__float_as_int(v), 0x140, 0xF, 0xF, true));
    return v;
  };
  h16 xr[10], xk[10], xv[10];
  u32x4 af[4];
  auto prefetch = [&](int n0) {
    const bool lat = n0 >= 256;
    const int L = lat ? 4096 : 256;
    const int rowbase = lat ? b * 4096 : TL + b * 256;
    const int nn = (lat ? n0 - 256 : n0);
    const int P0 = d ? (L - 1 - (nn + 8 * w)) : (nn + 8 * w);
#pragma unroll
    for (int q = 0; q < 10; ++q) {
      const int pq = d ? (P0 + 1 - q) : (P0 - 1 + q);
      h16 a_ = (h16)0.f, b_ = (h16)0.f, c_ = (h16)0.f;
      if (pq >= 0 && pq < L) {
        const h16* x1 = rkv + (size_t)(rowbase + pq) * 1536 + c;
        a_ = x1[0]; b_ = x1[512]; c_ = x1[1024];
      }
      xr[q] = a_; xk[q] = b_; xv[q] = c_;
    }
    const int nt = nn + (lane & 31);
    const int pt = d ? (L - 1 - nt) : nt;
    const h16* lp = lora + (size_t)(rowbase + pt) * 384 + mat * 128 + d * 64 + 8 * (lane >> 5);
#pragma unroll
    for (int ks = 0; ks < 4; ++ks) af[ks] = *(const u32x4*)(lp + ks * 16);
  };
  prefetch(0);
  __syncthreads();
  for (int n0 = 0; n0 < 256 + 4096; n0 += 32) {
    const bool lat = n0 >= 256;
    const int L = lat ? 4096 : 256;
    const int rowbase = lat ? b * 4096 : TL + b * 256;
    const int nn = (lat ? n0 - 256 : n0);
    {
      f32x16 acc;
#pragma unroll
      for (int i = 0; i < 16; ++i) acc[i] = 0.f;
#pragma unroll
      for (int ks = 0; ks < 4; ++ks) acc = MFMA(__builtin_bit_cast(h16x8, af[ks]), bf[ks], acc);
      float* rw = raw + mat * 2048 + nblk * 32 + (lane & 31);
#pragma unroll
      for (int i = 0; i < 16; ++i) rw[(4 * (lane >> 5) + (i & 3) + 8 * (i >> 2)) * 64] = acc[i];
    }
    __syncthreads();
#pragma unroll
    for (int e = 0; e < 8; ++e) {
      const int tt = 8 * w + e;
      const int n = nn + tt;
      const int pos = d ? (L - 1 - n) : n;
      const size_t row = (size_t)rowbase + pos;
      const float rr = trA * (float)xr[e] + tr1 * (float)xr[e + 1] + trC * (float)xr[e + 2];
      const float kx = tkA * (float)xk[e] + tk1 * (float)xk[e + 1] + tkC * (float)xk[e + 2];
      const float vv = tvA * (float)xv[e] + tv1 * (float)xv[e + 1] + tvC * (float)xv[e + 2];
      const float wr = w0 + raw[tt * 64 + lane], ar = a0 + raw[2048 + tt * 64 + lane];
      const float z = -wr;
      const float sp = fmaxf(z, 0.f) + __logf(1.f + __expf(-fabsf(z)));
      const float dec = __expf(-__expf(-sp - 0.5f));
      const float aa = sigmoidf_(ar);
      const float kkr = kx * kkc;
      const float kkn = kkr * __builtin_amdgcn_rsqf(fmaxf(wave_sum(kkr * kkr), 1e-24f));
      const float km = kx * (1.f + (aa - 1.f) * kac);
      const float bon = wave_sum(rr * km * rkc);
      if (lane == 0) bs[((size_t)d * TA + row) * 8 + h] = bon;
      ckk[tt * 64 + lane] = kkn; cw[tt * 64 + lane] = dec; cb[tt * 64 + lane] = kkn * aa;
      ck[tt * 64 + lane] = km; cr[tt * 64 + lane] = rr; cv[tt * 64 + lane] = vv;
    }
    __syncthreads();
    if (n0 + 32 < 256 + 4096) prefetch(n0 + 32);
    {
      const float* base = ckk + jq * 4;
      const float* vbase = cv + half * 32 + w * 8 + rg * 2;
      h16* sobase = so + (size_t)rowbase * 512 + h * 64 + half * 32 + w * 8 + rg * 2;
      f32x4 kkA, wwA, bbA, kmA, rrA, kkB, wwB, bbB, kmB, rrB;
      f32x2 vvA, vvB;
#define SCAN_LD(tt, kk, ww, bb, km, rr, vv)                                                              \
  kk = *(const f32x4*)(base + (tt) * 64); ww = *(const f32x4*)(base + 2048 + (tt) * 64);                 \
  bb = *(const f32x4*)(base + 4096 + (tt) * 64); km = *(const f32x4*)(base + 6144 + (tt) * 64);          \
  rr = *(const f32x4*)(base + 8192 + (tt) * 64); vv = *(const f32x2*)(vbase + (tt) * 64);
#define SCAN_STEP(tt, kk, ww, bb, km, rr, vv)                                                            \
  {                                                                                                      \
    f32x2 klo, khi, wlo, whi, blo, bhi, mlo, mhi, rlo, rhi;                                              \
    klo.x = kk.x; klo.y = kk.y; khi.x = kk.z; khi.y = kk.w; wlo.x = ww.x; wlo.y = ww.y; whi.x = ww.z; whi.y = ww.w; \
    blo.x = bb.x; blo.y = bb.y; bhi.x = bb.z; bhi.y = bb.w; mlo.x = km.x; mlo.y = km.y; mhi.x = km.z; mhi.y = km.w; \
    rlo.x = rr.x; rlo.y = rr.y; rhi.x = rr.z; rhi.y = rr.w;                                              \
    float sa_[2], y_[2];                                                                                 \
    _Pragma("unroll") for (int e = 0; e < 2; ++e) {                                                      \
      f32x2 t2 = S[e][0] * klo; t2 += S[e][1] * khi;                                                     \
      sa_[e] = -row16_sum(t2.x + t2.y);                                                                  \
    }                                                                                                    \
    _Pragma("unroll") for (int e = 0; e < 2; ++e) {                                                      \
      f32x2 sav; sav.x = sa_[e]; sav.y = sa_[e];                                                         \
      f32x2 vev; vev.x = vv[e]; vev.y = vv[e];                                                           \
      S[e][0] = S[e][0] * wlo; S[e][0] += sav * blo; S[e][0] += vev * mlo;                               \
      S[e][1] = S[e][1] * whi; S[e][1] += sav * bhi; S[e][1] += vev * mhi;                               \
      f32x2 t2 = S[e][0] * rlo; t2 += S[e][1] * rhi;                                                     \
      y_[e] = row16_sum(t2.x + t2.y);                                                                    \
    }                                                                                                    \
    if (jq == 0) {                                                                                       \
      const int n_ = nn + (tt);                                                                          \
      const int pos_ = d ? (L - 1 - n_) : n_;                                                            \
      h16x2 o_; o_.x = (h16)y_[0]; o_.y = (h16)y_[1];                                                    \
      *(h16x2*)(sobase + (size_t)pos_ * 512) = o_;                                                       \
    }                                                                                                    \
  }
      SCAN_LD(0, kkA, wwA, bbA, kmA, rrA, vvA)
#pragma unroll 1
      for (int tt = 0; tt < 32; tt += 2) {
        SCAN_LD(tt + 1, kkB, wwB, bbB, kmB, rrB, vvB)
        SCAN_STEP(tt, kkA, wwA, bbA, kmA, rrA, vvA)
        if (tt + 2 < 32) { SCAN_LD(tt + 2, kkA, wwA, bbA, kmA, rrA, vvA) }
        SCAN_STEP(tt + 1, kkB, wwB, bbB, kmB, rrB, vvB)
      }
#undef SCAN_LD
#undef SCAN_STEP
    }
  }
  __syncthreads();
}
DI void scan_chain_c(const P& p, int l, int chain, char* smem, const XcdBarrier* xb, const int* hint, int nhs) {
  const int tid = TIDX(), lane = tid & 63, w = tid >> 6, r = lane & 31, hh = lane >> 5;
  const int d = chain >> 6, b = (chain >> 3) & 7, h = chain & 7;
  float* raw = (float*)smem;
  float* GT = (float*)smem;
  b16* UTt = (b16*)(smem + 8192);
  float* tot = (float*)(smem + 16384);
  b16* Qt = (b16*)(smem + 17408);
  b16* Rt = (b16*)(smem + 22016);
  b16* Bt = (b16*)(smem + 26624);
  b16* Kt = (b16*)(smem + 31232);
  b16* BgT = (b16*)(smem + 35840);
  b16* KgT = (b16*)(smem + 40960);
  b16* VT = (b16*)(smem + 46080);
  b16* Sl = (b16*)(smem + 51200);
  float* Am = (float*)(smem + 60416);
  b16* Bm = (b16*)(smem + 65024);
  b16* A2 = (b16*)(smem + 67584);
  b16* B2 = (b16*)(smem + 70144);
  float* GL = (float*)(smem + 72704);
  const h16* rkv = (const h16*)(p.ws + OFF_R1);
  const h16* lora = rkv + (size_t)TA * 1536;
  float* bs = (float*)(p.ws + OFF_BS);
  h16* so = (h16*)(p.ws + OFF_HB) + (size_t)d * TA * 512;
  const int mat = w & 1, nblk = w >> 1;
  h16x8 bf[4];
  {
    const float* wsrc = (mat ? p.in[I_A2] : p.in[I_W2]) + ((size_t)(l * 2 + d) * 64) * 512 + h * 64 + nblk * 32 + r;
#pragma unroll
    for (int ks = 0; ks < 4; ++ks)
#pragma unroll
      for (int e = 0; e < 8; ++e) bf[ks][e] = (h16)wsrc[(size_t)(ks * 16 + 8 * hh + e) * 512];
  }
  const int c = h * 64 + lane;
  const float* cvp = p.in[I_CONV] + (size_t)l * 3 * 1536;
  const int jblk = w >> 1, iblk = w & 1;
  f32x16 Sacc;
#pragma unroll
  for (int i = 0; i < 16; ++i) Sacc[i] = 0.f;
  for (int i = tid; i < 64 * 72 / 2; i += 256) ((unsigned*)Sl)[i] = 0u;
  h16 xr[10], xk[10], xv[10];
  u32x4 af[4];
  auto prefetch = [&](int n0) {
    const bool lat = n0 >= 256;
    const int L = lat ? 4096 : 256;
    const int rowbase = lat ? b * 4096 : TL + b * 256;
    const int nn = (lat ? n0 - 256 : n0);
    const int P0 = d ? (L - 1 - (nn + 8 * w)) : (nn + 8 * w);
#pragma unroll
    for (int q = 0; q < 10; ++q) {
      const int pq = d ? (P0 + 1 - q) : (P0 - 1 + q);
      h16 a_ = (h16)0.f, b_ = (h16)0.f, c_ = (h16)0.f;
      if (pq >= 0 && pq < L) {
        const h16* x1 = rkv + (size_t)(rowbase + pq) * 1536 + c;
        a_ = x1[0]; b_ = x1[512]; c_ = x1[1024];
      }
      xr[q] = a_; xk[q] = b_; xv[q] = c_;
    }
  };
  auto prefetch_af = [&](int n0) {
    const bool lat = n0 >= 256;
    const int L = lat ? 4096 : 256;
    const int rowbase = lat ? b * 4096 : TL + b * 256;
    const int nn = (lat ? n0 - 256 : n0);
    const int nt = nn + r;
    const int pt = d ? (L - 1 - nt) : nt;
    const h16* lp = lora + (size_t)(rowbase + pt) * 384 + mat * 128 + d * 64 + 8 * hh;
#pragma unroll
    for (int ks = 0; ks < 4; ++ks) af[ks] = *(const u32x4*)(lp + ks * 16);
  };
  prefetch(0);
  prefetch_af(0);
  __syncthreads();
  const int lane_outer = lane;
  int* sflag = (int*)(smem + SMEM_BYTES - 12);
  int nsync = 0;
  const int ntarget = (int)gridDim.x - 128;
  for (int n0 = 0; n0 < 256 + 4096; n0 += 32) {
    const bool lat = n0 >= 256;
    const int L = lat ? 4096 : 256;
    const int rowbase = lat ? b * 4096 : TL + b * 256;
    const int nn = (lat ? n0 - 256 : n0);
    int lane = lane_outer;
    asm volatile("" : "+v"(lane));
    const int r = lane & 31, hh = lane >> 5;
    if (tid == 0) *sflag = (nsync < nhs) ? __hip_atomic_load(hint + nsync, __ATOMIC_RELAXED, __HIP_MEMORY_SCOPE_AGENT) : 0;
    {
      f32x16 acc;
#pragma unroll
      for (int i = 0; i < 16; ++i) acc[i] = 0.f;
#pragma unroll
      for (int ks = 0; ks < 4; ++ks) acc = MFMA(__builtin_bit_cast(h16x8, af[ks]), bf[ks], acc);
      float* rw = raw + mat * 2048 + nblk * 32 + r;
#pragma unroll
      for (int i = 0; i < 16; ++i) rw[(4 * hh + (i & 3) + 8 * (i >> 2)) * 64] = acc[i];
    }
    __syncthreads();
    const int arrived = *sflag;
    float lw[8], kkv[8], bbv[8], kmv[8], rrv[8], vvv[8], cl[8];
    float run = 0.f;
    const int cc = h * 64 + lane;
    const float w0 = p.in[I_W0][(l * 2 + d) * 512 + cc], a0 = p.in[I_A0][(l * 2 + d) * 512 + cc];
    const float kkc = p.in[I_KK][l * 512 + cc], kac = p.in[I_KA][l * 512 + cc], rkc = p.in[I_RK][l * 512 + cc];
    const float trA = cvp[(d ? 3072 : 0) + cc], tr1 = cvp[1536 + cc], trC = cvp[(d ? 0 : 3072) + cc];
    const float tkA = cvp[(d ? 3072 : 0) + 512 + cc], tk1 = cvp[1536 + 512 + cc], tkC = cvp[(d ? 0 : 3072) + 512 + cc];
    const float tvA = cvp[(d ? 3072 : 0) + 1024 + cc], tv1 = cvp[1536 + 1024 + cc], tvC = cvp[(d ? 0 : 3072) + 1024 + cc];
#pragma unroll
    for (int e = 0; e < 8; ++e) {
      const int tt = 8 * w + e;
      const int n = nn + tt;
      const int pos = d ? (L - 1 - n) : n;
      const size_t row = (size_t)rowbase + pos;
      const float rr = trA * (float)xr[e] + tr1 * (float)xr[e + 1] + trC * (float)xr[e + 2];
      const float kx = tkA * (float)xk[e] + tk1 * (float)xk[e + 1] + tkC * (float)xk[e + 2];
      const float vv = tvA * (float)xv[e] + tv1 * (float)xv[e + 1] + tvC * (float)xv[e + 2];
      const float wr = w0 + raw[tt * 64 + lane], ar = a0 + raw[2048 + tt * 64 + lane];
      const float z = -wr;
      const float sp = fmaxf(z, 0.f) + __logf(1.f + __expf(-fabsf(z)));
      const float lgw = -__expf(-sp - 0.5f);
      const float aa = sigmoidf_(ar);
      const float kkr = kx * kkc;
      const float kkn = kkr * __builtin_amdgcn_rsqf(fmaxf(wave_sum(kkr * kkr), 1e-24f));
      const float km = kx * (1.f + (aa - 1.f) * kac);
      const float bon = wave_sum(rr * km * rkc);
      if (lane == 0) bs[((size_t)d * TA + row) * 8 + h] = bon;
      run += lgw;
      lw[e] = lgw; cl[e] = run; kkv[e] = kkn; bbv[e] = kkn * aa; kmv[e] = km; rrv[e] = rr; vvv[e] = vv;
    }
    tot[w * 64 + lane] = run;
    __syncthreads();
    {
      const float t0 = tot[lane], t1 = tot[64 + lane], t2 = tot[128 + lane], t3 = tot[192 + lane];
      const float total = t0 + t1 + t2 + t3;
      const float prefix = (w > 0 ? t0 : 0.f) + (w > 1 ? t1 : 0.f) + (w > 2 ? t2 : 0.f);
      if (w == 0) GL[lane] = __expf(total);
      b16x8 bgv, kgv, vtv;
#pragma unroll
      for (int e = 0; e < 8; ++e) {
        const int tt = 8 * w + e;
        const float g = prefix + cl[e];
        const float eg = __expf(g), ege = __expf(g - lw[e]);
        const float eng = __builtin_amdgcn_rcpf(eg);
        const float egl = __expf(total - g);
        Qt[tt * 72 + lane] = (b16)(kkv[e] * ege);
        Rt[tt * 72 + lane] = (b16)(rrv[e] * eg);
        Bt[tt * 72 + lane] = (b16)(bbv[e] * eng);
        Kt[tt * 72 + lane] = (b16)(kmv[e] * eng);
        bgv[e] = (b16)(bbv[e] * egl);
        kgv[e] = (b16)(kmv[e] * egl);
        vtv[e] = (b16)vvv[e];
      }
      *(b16x8*)(BgT + lane * 40 + 8 * w) = bgv;
      *(b16x8*)(KgT + lane * 40 + 8 * w) = kgv;
      *(b16x8*)(VT + lane * 40 + 8 * w) = vtv;
    }
    __syncthreads();
    {
      const b16* X = (w < 2) ? Qt : Rt;
      const b16* Y = (w & 1) ? Kt : Bt;
      f32x16 acc;
#pragma unroll
      for (int i = 0; i < 16; ++i) acc[i] = 0.f;
#pragma unroll
      for (int ks = 0; ks < 4; ++ks) {
        b16x8 a = *(const b16x8*)(X + r * 72 + ks * 16 + 8 * hh);
        b16x8 bb = *(const b16x8*)(Y + r * 72 + ks * 16 + 8 * hh);
        acc = MFMAB(a, bb, acc);
      }
#pragma unroll
      for (int i = 0; i < 16; ++i) {
        const int t = 4 * hh + (i & 3) + 8 * (i >> 2);
        const bool keep = (w < 2) ? (r < t) : (r <= t);
        const float v = keep ? acc[i] : 0.f;
        if (w == 0) Am[t * 36 + r] = v;
        else if (w == 1) Bm[t * 40 + r] = (b16)v;
        else if (w == 2) A2[t * 40 + r] = (b16)v;
        else B2[t * 40 + r] = (b16)v;
      }
    }
    __syncthreads();
    if (w < 2) {
      f32x16 acc;
#pragma unroll
      for (int i = 0; i < 16; ++i) acc[i] = 0.f;
#pragma unroll
      for (int ks = 0; ks < 4; ++ks) {
        b16x8 a = *(const b16x8*)(Qt + r * 72 + ks * 16 + 8 * hh);
        b16x8 bb = *(const b16x8*)(Sl + (iblk * 32 + r) * 72 + ks * 16 + 8 * hh);
        acc = MFMAB(a, bb, acc);
      }
#pragma unroll
      for (int ks = 0; ks < 2; ++ks) {
        b16x8 a = *(const b16x8*)(Bm + r * 40 + ks * 16 + 8 * hh);
        b16x8 bb = *(const b16x8*)(VT + (iblk * 32 + r) * 40 + ks * 16 + 8 * hh);
        acc = MFMAB(a, bb, acc);
      }
#pragma unroll
      for (int i = 0; i < 16; ++i) GT[(4 * hh + (i & 3) + 8 * (i >> 2)) * 64 + iblk * 32 + r] = -acc[i];
    }
    __syncthreads();
    {
      if (n0 + 32 < 256 + 4096) prefetch_af(n0 + 32);
      const int q = lane & 3, col = 16 * w + (lane >> 2);
      float uq[8];
#pragma unroll
      for (int e = 0; e < 8; ++e) uq[e] = 0.f;
      int o0 = 0, o1 = 0;
#pragma unroll
      for (int t = 0; t < 32; ++t) {
        const int oo = (t & 1) ? o1 : o0;
        const float gt = GT[t * 64 + col + oo];
        float ut = gt;
        if (t > 0) {
          const f32x4 am0 = *(const f32x4*)(Am + t * 36 + 8 * q + oo);
          const f32x4 am1 = *(const f32x4*)(Am + t * 36 + 8 * q + 4 + oo);
          float part = (am0.x * uq[0] + am0.y * uq[1]) + (am0.z * uq[2] + am0.w * uq[3]);
          part += (am1.x * uq[4] + am1.y * uq[5]) + (am1.z * uq[6] + am1.w * uq[7]);
          ut = gt - quad_sum(part);
        }
        uq[t & 7] = (q == (t >> 3)) ? ut : uq[t & 7];
        if (t & 1) asm volatile("" : "+v"(o1) : "v"(ut)); else asm volatile("" : "+v"(o0) : "v"(ut));
      }
      b16x8 o;
#pragma unroll
      for (int e = 0; e < 8; ++e) o[e] = (b16)uq[e];
      *(b16x8*)(UTt + col * 40 + 8 * q) = o;
      if (n0 + 32 < 256 + 4096) prefetch(n0 + 32);
    }
    __syncthreads();
    if (w >= 2) {
      f32x16 Yacc;
#pragma unroll
      for (int i = 0; i < 16; ++i) Yacc[i] = 0.f;
#pragma unroll
      for (int ks = 0; ks < 4; ++ks) {
        b16x8 a = *(const b16x8*)(Rt + r * 72 + ks * 16 + 8 * hh);
        b16x8 bb = *(const b16x8*)(Sl + (iblk * 32 + r) * 72 + ks * 16 + 8 * hh);
        Yacc = MFMAB(a, bb, Yacc);
      }
#pragma unroll
      for (int ks = 0; ks < 2; ++ks) {
        b16x8 a = *(const b16x8*)(B2 + r * 40 + ks * 16 + 8 * hh);
        b16x8 bb = *(const b16x8*)(VT + (iblk * 32 + r) * 40 + ks * 16 + 8 * hh);
        Yacc = MFMAB(a, bb, Yacc);
      }
#pragma unroll
      for (int ks = 0; ks < 2; ++ks) {
        b16x8 a = *(const b16x8*)(A2 + r * 40 + ks * 16 + 8 * hh);
        b16x8 bb = *(const b16x8*)(UTt + (iblk * 32 + r) * 40 + ks * 16 + 8 * hh);
        Yacc = MFMAB(a, bb, Yacc);
      }
#pragma unroll
      for (int i = 0; i < 16; ++i) {
        const int t = 4 * hh + (i & 3) + 8 * (i >> 2);
        const int n = nn + t;
        const int pos = d ? (L - 1 - n) : n;
        so[((size_t)rowbase + pos) * 512 + h * 64 + iblk * 32 + r] = (h16)Yacc[i];
      }
    }
    __syncthreads();
    {
#pragma unroll
      for (int g4 = 0; g4 < 4; ++g4) {
        const f32x4 gl4 = *(const f32x4*)(GL + jblk * 32 + 8 * g4 + 4 * hh);
        Sacc[4 * g4 + 0] *= gl4.x; Sacc[4 * g4 + 1] *= gl4.y; Sacc[4 * g4 + 2] *= gl4.z; Sacc[4 * g4 + 3] *= gl4.w;
      }
#pragma unroll
      for (int ks = 0; ks < 2; ++ks) {
        b16x8 a = *(const b16x8*)(BgT + (jblk * 32 + r) * 40 + ks * 16 + 8 * hh);
        b16x8 bb = *(const b16x8*)(UTt + (iblk * 32 + r) * 40 + ks * 16 + 8 * hh);
        Sacc = MFMAB(a, bb, Sacc);
      }
#pragma unroll
      for (int ks = 0; ks < 2; ++ks) {
        b16x8 a = *(const b16x8*)(KgT + (jblk * 32 + r) * 40 + ks * 16 + 8 * hh);
        b16x8 bb = *(const b16x8*)(VT + (iblk * 32 + r) * 40 + ks * 16 + 8 * hh);
        Sacc = MFMAB(a, bb, Sacc);
      }
#pragma unroll
      for (int g4 = 0; g4 < 4; ++g4) {
        b16x4 o;
        o.x = (b16)Sacc[4 * g4 + 0]; o.y = (b16)Sacc[4 * g4 + 1]; o.z = (b16)Sacc[4 * g4 + 2]; o.w = (b16)Sacc[4 * g4 + 3];
        *(b16x4*)(Sl + (iblk * 32 + r) * 72 + jblk * 32 + 8 * g4 + 4 * hh) = o;
      }
    }
    __syncthreads();
    if (nsync < nhs && arrived >= ntarget) { xcd_barrier(*xb); ++nsync; }
  }
  while (nsync < nhs) { xcd_barrier(*xb); ++nsync; }
}

DI void phase_attn(const P& p, int l, int rep, char* smem) {
  const int xcd = BIDX() & 7, j = BIDX() >> 3;
  if (j < 16 && !(rep == 1 && DUPMODE == 2)) {
    __builtin_amdgcn_s_setprio(3);
    scan_chain_c(p, l, (j >> 3) * 64 + xcd * 8 + (j & 7), smem, nullptr, nullptr, 0);
    __builtin_amdgcn_s_setprio(0);
  }
  if (rep == 1 && DUPMODE == 1) return;
  int* ctr = (int*)(p.ws + OFF_CTR) + (rep * 2 + l) * 8 + xcd;
  const int nit = (l == 1) ? 512 : 544;
  int* sit = (int*)(smem + SMEM_BYTES - 16);
  for (;;) {
    __syncthreads();
    if (TIDX() == 0) *sit = atomicAdd(ctr, 1);
    __syncthreads();
    const int it = *sit;
    if (it >= nit) break;
    attn_dispatch(p, xcd, it, smem);
  }
}

DI void phase_mixer(const P& p, int l, const XcdBarrier& xb, char* smem) {
  const int xcd = BIDX() & 7, j = BIDX() >> 3;
  int* cbase = (int*)(p.ws + OFF_CTR);
  int* hint = cbase + 40 + l * 2;
  if (j < 16) {
    __builtin_amdgcn_s_setprio(3);
    scan_chain_c(p, l, (j >> 3) * 64 + xcd * 8 + (j & 7), smem, &xb, hint, 2);
    __builtin_amdgcn_s_setprio(0);
  } else {
    const int geff = (int)gridDim.x - 128;
    phase_prep(p, l, 128, geff);
    __syncthreads();
    if (TIDX() == 0) atomicAdd(hint, 1);
    xcd_barrier(xb);
    phase_uproj(p, l, smem, 128, geff);
    __syncthreads();
    if (TIDX() == 0) atomicAdd(hint + 1, 1);
    xcd_barrier(xb);
  }
  int* ctr = cbase + l * 8 + xcd;
  const int nit = (l == 1) ? 512 : 544;
  int* sit = (int*)(smem + SMEM_BYTES - 16);
  for (;;) {
    __syncthreads();
    if (TIDX() == 0) *sit = atomicAdd(ctr, 1);
    __syncthreads();
    const int it = *sit;
    if (it >= nit) break;
    attn_dispatch(p, xcd, it, smem);
  }
}

DI void phase_post(const P& p, int l, char* smem) {
  const h16* W = (const h16*)(p.ws + OFF_W16) + WO_G2;
  h16* rkv = (h16*)(p.ws + OFF_R1);
  const h16* lora = rkv + (size_t)TA * 1536;
  const h16* sof = (const h16*)(p.ws + OFF_HB);
  const h16* sob = sof + (size_t)TA * 512;
  const float* bs = (const float*)(p.ws + OFF_BS);
  const float* lng = p.in[I_LNG] + l * 512;
  const float* lnb = p.in[I_LNB] + l * 512;
  const float* cvp = p.in[I_CONV] + (size_t)l * 3 * 1536 + 1024;
  const int ntok = (l == 1) ? 256 : 272;
  const int nt = 4 * ntok;
  const int lane = TIDX() & 63, w = TIDX() >> 6, wm = w >> 1, wn = w & 1, hh = lane >> 5;
  for (int t = BIDX(); t < nt; t += gridDim.x) {
    const int m0 = (t & 3) * 128, n0 = (t >> 2) * 128;
    f32x16 acc[2][2];
    zero_acc(acc);
    gemm_tile(W + (size_t)m0 * 128, 128, lora + (size_t)n0 * 384 + 256, 384, 128, acc, (h16*)smem);
    const int head = (m0 + wm * 64) >> 6;
#pragma unroll
    for (int ni = 0; ni < 2; ++ni) {
      const int row = n0 + wn * 64 + ni * 32 + (lane & 31);
      const bool lat = row < TL;
      const int pos = lat ? (row & 4095) : ((row - TL) & 255);
      const int L = lat ? 4096 : 256;
      float y[2][16];
      float sum = 0.f;
#pragma unroll
      for (int mi = 0; mi < 2; ++mi)
#pragma unroll
        for (int g = 0; g < 4; ++g) {
          const int cb_ = m0 + wm * 64 + mi * 32 + 8 * g + 4 * hh;
          h16x4 f = *(const h16x4*)(sof + (size_t)row * 512 + cb_), bk = *(const h16x4*)(sob + (size_t)row * 512 + cb_);
          y[mi][4 * g + 0] = (float)f.x + (float)bk.x; y[mi][4 * g + 1] = (float)f.y + (float)bk.y;
          y[mi][4 * g + 2] = (float)f.z + (float)bk.z; y[mi][4 * g + 3] = (float)f.w + (float)bk.w;
          sum += y[mi][4 * g] + y[mi][4 * g + 1] + y[mi][4 * g + 2] + y[mi][4 * g + 3];
        }
      sum += shx(sum, 32);
      const float mean = sum * (1.f / 64.f);
      float vs = 0.f;
#pragma unroll
      for (int mi = 0; mi < 2; ++mi)
#pragma unroll
        for (int i = 0; i < 16; ++i) { const float dlt = y[mi][i] - mean; vs += dlt * dlt; }
      vs += shx(vs, 32);
      const float rstd = rsqrtf(vs * (1.f / 64.f) + 64e-5f);
      const float bsum = bs[(size_t)row * 8 + head] + bs[((size_t)TA + row) * 8 + head];
#pragma unroll
      for (int mi = 0; mi < 2; ++mi)
#pragma unroll
        for (int g = 0; g < 4; ++g) {
          const int cb_ = m0 + wm * 64 + mi * 32 + 8 * g + 4 * hh;
          const h16* vp = rkv + (size_t)row * 1536 + 1024 + cb_;
          h16x4 v1 = *(const h16x4*)vp, v0, v2;
          v0.x = v0.y = v0.z = v0.w = (h16)0.f; v2 = v0;
          if (pos > 0) v0 = *(const h16x4*)(vp - 1536);
          if (pos < L - 1) v2 = *(const h16x4*)(vp + 1536);
          h16x4 o;
#pragma unroll
          for (int e = 0; e < 4; ++e) {
            const int cc = cb_ + e;
            const float vv = cvp[cc] * (float)v0[e] + cvp[1536 + cc] * (float)v1[e] + cvp[3072 + cc] * (float)v2[e];
            const float val = ((y[mi][4 * g + e] - mean) * rstd * lng[cc] + lnb[cc] + bsum * vv) * acc[mi][ni][4 * g + e];
            o[e] = (h16)val;
          }
          *(h16x4*)(rkv + (size_t)row * 1536 + cb_) = o;
        }
      __builtin_amdgcn_sched_barrier(0);
    }
  }
  const float* xl = l == 0 ? p.in[I_X] : p.out;
  const float* xc = l == 0 ? p.in[I_CTX] : (const float*)(p.ws + OFF_XC);
  rows_norm_mod(p, xl, xc, l, p.in[I_APRE] + l * 1024, 0, 1, (h16*)(p.ws + OFF_HRE), (l == 1) ? TL : TA);
}

DI void phase_merge(const P& p, int l, char* smem) {
  const h16* W = (const h16*)(p.ws + OFF_W16);
  const h16* hre = (const h16*)(p.ws + OFF_HRE);
  const h16* oa = (const h16*)(p.ws + OFF_X);
  const h16* ob = oa + (size_t)TA * 512;
  const h16* oc = (const h16*)(p.ws + OFF_R1);
  h16* accb = (h16*)(p.ws + OFF_ACC);
  const int Mx = (l == 1) ? 32 : 34;
  XCD_LOOP(Mx, 8) {
    int mt_, nt_;
    tile_map(u_, Mx, 8, xcd_, mt_, nt_);
    const int m0 = mt_ * 128, n0 = nt_ * 128;
    h16x2 accp[2][2][8];
#pragma unroll
    for (int a = 0; a < 2; ++a)
#pragma unroll
      for (int bq = 0; bq < 2; ++bq)
#pragma unroll
        for (int i = 0; i < 8; ++i) { accp[a][bq][i].x = (h16)0.f; accp[a][bq][i].y = (h16)0.f; }
    u32x4 cra[4], crb[4];
#pragma unroll 1
    for (int n = 0; n < 3; ++n) {
      h16x2 gp[2][2][8];
      const h16* br = n == 0 ? oa + (size_t)m0 * 512 : (n == 1 ? ob + (size_t)m0 * 512 : oc + (size_t)m0 * 1536);
      const int ldbr = n == 2 ? 1536 : 512;
      const h16* wbr = W + WO_WB + ((size_t)n * 1024 + n0) * 512;
      {
        f32x16 ag[2][2];
        zero_acc(ag);
        gemm_tile_c(hre + (size_t)m0 * 1024, 1024, W + WO_WIN + (size_t)(3360 + n * 1024 + n0) * 1024, 1024, 1024, ag, (h16*)smem,
                    cra, crb, n > 0, br, ldbr, wbr, 512);
#pragma unroll
        for (int a = 0; a < 2; ++a)
#pragma unroll
          for (int bq = 0; bq < 2; ++bq)
#pragma unroll
            for (int i = 0; i < 8; ++i) {
              h16x2 t; t.x = (h16)sigmoidf_(ag[a][bq][2 * i]); t.y = (h16)sigmoidf_(ag[a][bq][2 * i + 1]);
              gp[a][bq][i] = t;
            }
      }
      f32x16 ab[2][2];
      zero_acc(ab);
      gemm_tile_c(br, ldbr, wbr, 512, 512, ab, (h16*)smem, cra, crb, true,
                  n < 2 ? hre + (size_t)m0 * 1024 : nullptr, 1024, W + WO_WIN + (size_t)(3360 + (n + 1) * 1024 + n0) * 1024, 1024);
#pragma unroll
      for (int a = 0; a < 2; ++a)
#pragma unroll
        for (int bq = 0; bq < 2; ++bq)
#pragma unroll
          for (int i = 0; i < 8; ++i) {
            h16x2 t;
            t.x = (h16)((float)accp[a][bq][i].x + (float)gp[a][bq][i].x * ab[a][bq][2 * i]);
            t.y = (h16)((float)accp[a][bq][i].y + (float)gp[a][bq][i].y * ab[a][bq][2 * i + 1]);
            accp[a][bq][i] = t;
          }
    }
    {
      const int lane = TIDX() & 63, w = TIDX() >> 6, wm = w >> 1, wn = w & 1, hh = lane >> 5, c = lane & 31;
#pragma unroll
      for (int mi = 0; mi < 2; ++mi)
#pragma unroll
        for (int ni = 0; ni < 2; ++ni) {
          const int rbase = m0 + wm * 64 + mi * 32 + 4 * hh, n = n0 + wn * 64 + ni * 32 + c;
#pragma unroll
          for (int i = 0; i < 8; ++i) {
            accb[(size_t)EROW(rbase, 2 * i) * 1024 + n] = accp[mi][ni][i].x;
            accb[(size_t)EROW(rbase, 2 * i + 1) * 1024 + n] = accp[mi][ni][i].y;
          }
        }
    }
  }
}

DI void phase_gemm_plain(const h16* A, int lda, const h16* Bt, int K, h16* C, int ldc, int mt0, int mt1, int ntn, char* smem) {
  const int Mx = (mt1 - mt0) >> 3;
  XCD_LOOP(Mx, ntn) {
    int mt_, nt_;
    tile_map(u_, Mx, ntn, xcd_, mt_, nt_);
    const int m0 = (mt0 + mt_) * 128, n0 = nt_ * 128;
    f32x16 acc[2][2];
    zero_acc(acc);
    gemm_tile_deep(A + (size_t)m0 * lda, lda, Bt + (size_t)n0 * K, K, K, acc, (h16*)smem);
    epi_foreach(acc, m0, n0, [&](int rbase, int n, const f32x16& v) {
#pragma unroll
      for (int i = 0; i < 16; ++i) C[(size_t)EROW(rbase, i) * ldc + n] = (h16)v[i];
    });
  }
}

DI void phase_ffn1(const P& p, int l, int hf, char* smem) {
  const h16* W = (const h16*)(p.ws + OFF_W16) + WO_FIN;
  const h16* h2 = (const h16*)(p.ws + OFF_X);
  h16* act = (h16*)(p.ws + OFF_HB);
  const int mt0 = 0;
  const int mt1 = (l == 1) ? 256 : 272;
  const int Mt = (mt1 - mt0) >> 1;
  XCD_LOOP_W(Mt, 44) {
    int mt_, nt_;
    tile_map(u_, Mx_, 44, xcd_, mt_, nt_);
    if (mt_ >= Mt) continue;
    const int m0 = mt0 * 128 + mt_ * 256, c0 = nt_ * 64;
    f32x16 acc[4][2];
    zero_acc_w(acc);
    gemm_tile_w(h2 + (size_t)m0 * 1024, 1024, W, 1024,
                [&](int rr) { const int q = rr & 63; return ((q >> 5) ? 2816 : 0) + c0 + (rr >> 6) * 32 + (q & 31); }, 1024, acc, (h16*)smem);
    const int lane = TIDX() & 63, w = TIDX() >> 6, wm = w >> 1, wn = w & 1, hh = lane >> 5, c = lane & 31;
    const int ml0 = m0 - mt0 * 128;
#pragma unroll
    for (int mi = 0; mi < 4; ++mi) {
      const int rbase = ml0 + wm * 128 + mi * 32 + 4 * hh, n = c0 + wn * 32 + c;
#pragma unroll
      for (int i = 0; i < 16; ++i) {
        const float g = acc[mi][0][i];
        act[(size_t)EROW(rbase, i) * 2816 + n] = (h16)(g * sigmoidf_(g) * acc[mi][1][i]);
      }
    }
  }
}
DI void phase_ffn2(const P& p, int l, int hf, char* smem) {
  const h16* W = (const h16*)(p.ws + OFF_W16) + WO_FOUT;
  const h16* act = (const h16*)(p.ws + OFF_HB);
  h16* f = (h16*)(p.ws + OFF_QM);
  phase_gemm_plain(act, 2816, W, 2816, f, 1024, 0, (l == 1) ? 256 : 272, 8, smem);
}

#if BENCH
DI void phase_bench(const P& p, char* smem) {
  const int lane = TIDX() & 63;
  f32x16 c0, c1, c2, c3;
#pragma unroll
  for (int i = 0; i < 16; ++i) { c0[i] = 0.f; c1[i] = 0.f; c2[i] = 0.f; c3[i] = 0.f; }
  h16x8 a, b;
#pragma unroll
  for (int i = 0; i < 8; ++i) { a[i] = (h16)(0.001f * (lane + i)); b[i] = (h16)(0.002f * (lane - i)); }
#pragma unroll 1
  for (int it = 0; it < 4096; ++it) {
    c0 = MFMA(a, b, c0); c1 = MFMA(a, b, c1); c2 = MFMA(a, b, c2); c3 = MFMA(a, b, c3);
  }
  float r = c0[0] + c1[1] + c2[2] + c3[3];
  if (r == 123.456f) ((float*)(p.ws + OFF_CTR))[60] = r;
}
#endif
enum { PH_INIT = 0, PH_NORM0, PH_PROJ, PH_PREP, PH_UPROJ, PH_ATTN, PH_SCAN, PH_POST, PH_MERGE, PH_WOUT, PH_RES1, PH_FFN1, PH_FFN2, PH_RES2 };

DI void run_phase(const P& p, int ph, int l, int hf, char* smem) {
  const int nrows = (l == 1) ? TL : TA;
  const float* xl = l == 0 ? p.in[I_X] : p.out;
  const float* xc = l == 0 ? p.in[I_CTX] : (const float*)(p.ws + OFF_XC);
  switch (ph) {
    case PH_INIT: phase_init(p, smem); break;
    case PH_NORM0: rows_norm_mod(p, p.in[I_X], p.in[I_CTX], 0, p.in[I_APRE], 0, 1, (h16*)(p.ws + OFF_HB), TA); break;
    case PH_PROJ: phase_proj(p, l, smem); break;
    case PH_PREP: phase_prep(p, l, 0, (int)gridDim.x); break;
    case PH_UPROJ: phase_uproj(p, l, smem, 0, (int)gridDim.x); break;
    case PH_ATTN: phase_attn(p, l, hf, smem); break;
    case PH_POST: phase_post(p, l, smem); break;
    case PH_MERGE: phase_merge(p, l, smem); break;
    case PH_WOUT:
      phase_gemm_plain((const h16*)(p.ws + OFF_ACC), 1024, (const h16*)(p.ws + OFF_W16) + WO_WOUT, 1024, (h16*)(p.ws + OFF_HB), 1024, 0,
                       (l == 1) ? 256 : 272, 8, smem);
      break;
    case PH_RES1:
      rows_resid_norm(p, xl, xc, (const h16*)(p.ws + OFF_HB), l, 2, p.in[I_APOST] + l * 1024, true, l, p.in[I_FPRE] + l * 1024, 3, 4,
                      (h16*)(p.ws + OFF_X), nrows);
      break;
    case PH_FFN1: phase_ffn1(p, l, hf, smem); break;
    case PH_FFN2: phase_ffn2(p, l, hf, smem); break;
    case PH_RES2:
      rows_resid_norm(p, p.out, (const float*)(p.ws + OFF_XC), (const h16*)(p.ws + OFF_QM), l, 5, p.in[I_FPOST] + l * 1024, l == 0, 1,
                      p.in[I_APRE] + 1024, 0, 1, (h16*)(p.ws + OFF_HB), nrows);
      if (l == 0) conv_weights(p, 1, smem);
      break;
  }
}

template <int PH>
__global__ void __launch_bounds__(256) k_phase(P p, int l, int hf) {
  __shared__ __attribute__((aligned(16))) char smem[SMEM_BYTES];
  run_phase(p, PH, l, hf, smem);
}

#if MEGA
__global__ void __launch_bounds__(256, 2) k_mega(P p) {
  __shared__ __attribute__((aligned(16))) char smem[SMEM_BYTES];
  cg::grid_group grid = cg::this_grid();
  __shared__ __attribute__((aligned(16))) unsigned xb_words[4];
  if (threadIdx.x < 4) xb_words[threadIdx.x] = 0u;
  __syncthreads();
  const XcdBarrier xb = xcd_barrier_post((unsigned*)(p.ws + OFF_BAR), (volatile LAS unsigned*)xb_words);
#pragma unroll 1
  for (int step = 0; step < 20; ++step) {
    int ph, l = 0, hf = 0;
    if (step < 2) ph = step;
    else {
      const int s = step - 2;
      l = s / 9;
      const int k = s - l * 9;
      ph = (k == 0) ? PH_PROJ : (k == 1 ? 14 : k + 5);
    }
    P q = p;
    size_t z0 = 0;
    asm volatile("" : "+s"(z0));
    q.ws = p.ws + z0;
    q.out = p.out + z0;
    if (ph == 14) phase_mixer(q, l, xb, smem);
    else run_phase(q, ph, l, hf, smem);
#if BENCH
    if (step == 0) { grid.sync(); phase_bench(q, smem); }
#endif
#if DUPMASK
    if ((DUPMASK >> ph) & 1) {
      grid.sync();
      run_phase(q, ph, l, ph == PH_ATTN ? 1 : hf, smem);
    }
#endif
    if (step < 19) xcd_barrier(xb);
    if (gridDim.y == 7777u) grid.sync();
  }
}
#endif

extern "C" void kernel_launch(void* const* d_in, const int* in_sizes, int n_in, void* d_out, int out_size, void* d_ws, size_t ws_size,
                              hipStream_t stream) {
  P p{};
  for (int i = 0; i < N_IN; ++i) p.in[i] = (const float*)d_in[i];
  p.out = (float*)d_out;
  p.ws = (char*)d_ws;
  if (ws_size < OFF_END) { fprintf(stderr, "workspace too small: %zu < %zu\n", ws_size, (size_t)OFF_END); return; }
#if MEGA
  static int grid_blocks = 0;
  if (!grid_blocks) {
    int dev = 0, cus = 0, per_cu = 0;
    hipGetDevice(&dev);
    hipDeviceGetAttribute(&cus, hipDeviceAttributeMultiprocessorCount, dev);
    hipOccupancyMaxActiveBlocksPerMultiprocessor(&per_cu, k_mega, 256, 0);
    if (per_cu > 2) per_cu = 2;
    grid_blocks = cus * per_cu;
  }
  hipMemsetAsync((char*)d_ws + OFF_BAR, 0, 3456 * 4, stream);
  void* args[] = {&p};
  hipError_t e = hipLaunchCooperativeKernel((void*)k_mega, dim3(grid_blocks), dim3(256), args, 0, stream);
  if (e != hipSuccess) fprintf(stderr, "cooperative launch failed: %s (grid %d)\n", hipGetErrorString(e), grid_blocks);
#else
  const int G = 512;
#define L(ph, l, hf) hipLaunchKernelGGL(k_phase<ph>, dim3(G), dim3(256), 0, stream, p, l, hf)
  L(PH_INIT, 0, 0);
  L(PH_NORM0, 0, 0);
  for (int l = 0; l < 2; ++l) {
    L(PH_PROJ, l, 0); L(PH_PREP, l, 0); L(PH_UPROJ, l, 0); L(PH_ATTN, l, 0); L(PH_POST, l, 0); L(PH_MERGE, l, 0);
    L(PH_WOUT, l, 0); L(PH_RES1, l, 0); L(PH_FFN1, l, 0); L(PH_FFN2, l, 0); L(PH_RES2, l, 0);
  }
#undef L
#endif
}
```
